# Optimizing an MI355X kernel written in HIP

```python
import jax, jax.numpy as jnp
from jax import lax
import numpy as np

D_MODEL = 2048
BATCH = 8
SEQ = 2048
DEPTH = 2

CHUNK = 64
EPS = 1e-6
HEAD_DIM = 128
N_BRANCH = 4
BR_HEADS = 4
BR_WIDTH = BR_HEADS * HEAD_DIM
CONV_WIDTH = 3
SG_BLOCK = 128
ATT_PREV_CHUNKS = 8
BAND = (ATT_PREV_CHUNKS + 1) * CHUNK
REL_CLIP = 128
N_REL = 2 * REL_CLIP + 1
ROPE_THETA = 10000.0
IDX_HEADS = 16
IDX_DIM = 64
DSA_TOPK_MAX = 256
DSA_QBLOCK = CHUNK
PEER_HEADS = 8
PEER_NKEYS = 128
PEER_EXPERTS = PEER_NKEYS * PEER_NKEYS
PEER_QDIM = 256
PEER_HALF = PEER_QDIM // 2
PEER_TOPK = 16
PEER_TBLOCK = 128
PROJ_SIZES = (3 * BR_WIDTH, 2 * BR_WIDTH, 3 * BR_WIDTH, 3 * BR_WIDTH, IDX_HEADS * IDX_DIM, IDX_DIM, IDX_HEADS, N_BRANCH * D_MODEL)
P_IN = sum(PROJ_SIZES)

kernel_name = 'hybrid_streaming_encoder_block'


def rms_norm(x, g):
    xf = x.astype(jnp.float32)
    y = xf * lax.rsqrt(jnp.mean(xf * xf, axis=-1, keepdims=True) + EPS)
    return (y * g.astype(jnp.float32)).astype(x.dtype)


def split_cols(h, sizes):
    offs = [int(o) for o in np.cumsum(sizes)[:-1]]
    return jnp.split(h, offs, axis=-1)


def rotary(x, pos):
    hd = x.shape[-1]
    inv = ROPE_THETA ** (-jnp.arange(0, hd, 2, dtype=jnp.float32) / hd)
    ang = pos.astype(jnp.float32)[:, None] * inv[None, :]
    cos = jnp.cos(ang)[None, :, None, :]
    sin = jnp.sin(ang)[None, :, None, :]
    xf = x.astype(jnp.float32)
    x1, x2 = xf[..., : hd // 2], xf[..., hd // 2:]
    return jnp.concatenate([x1 * cos - x2 * sin, x2 * cos + x1 * sin], axis=-1).astype(x.dtype)


def short_conv_branch(a_in, conv_w):
    gb, gc, hv = jnp.split(a_in, 3, axis=-1)
    z = gc * hv
    rhs = conv_w.astype(z.dtype)[:, None, :]
    y = lax.conv_general_dilated(z, rhs, window_strides=(1,), padding=[(CONV_WIDTH - 1, 0)],
                                 dimension_numbers=('NWC', 'WIO', 'NWC'), feature_group_count=BR_WIDTH)
    return gb * y


def spatial_gating_branch(b_in, norm_g, w_s, b_s):
    B, S, _ = b_in.shape
    u, v = jnp.split(b_in, 2, axis=-1)
    v = rms_norm(v, norm_g)
    n = S // SG_BLOCK
    vb = v.reshape(B, n, SG_BLOCK, BR_HEADS, HEAD_DIM)
    causal = jnp.tril(jnp.ones((SG_BLOCK, SG_BLOCK), dtype=bool))
    w = jnp.where(causal[None], w_s, jnp.zeros((), w_s.dtype))
    mixed = jnp.einsum('gts,bnsgc->bntgc', w, vb) + b_s.T[None, None, :, :, None]
    return (u.reshape(B, n, SG_BLOCK, BR_HEADS, HEAD_DIM) * mixed).reshape(B, S, BR_WIDTH)


def chunk_band_attention(c_in, rel_bias):
    B, S, _ = c_in.shape
    nc = S // CHUNK
    q, k, v = [t.reshape(B, nc, CHUNK, BR_HEADS, HEAD_DIM) for t in jnp.split(c_in, 3, axis=-1)]
    pad = ((0, 0), (ATT_PREV_CHUNKS, 0), (0, 0), (0, 0), (0, 0))
    band = jnp.arange(nc)[:, None] + jnp.arange(ATT_PREV_CHUNKS + 1)[None, :]
    kb = jnp.pad(k, pad)[:, band].reshape(B, nc, BAND, BR_HEADS, HEAD_DIM)
    vb = jnp.pad(v, pad)[:, band].reshape(B, nc, BAND, BR_HEADS, HEAD_DIM)
    kk = jnp.arange(BAND)
    tq = jnp.arange(CHUNK)
    dist = CHUNK * (ATT_PREV_CHUNKS - kk // CHUNK)[None, :] + tq[:, None] - (kk % CHUNK)[None, :]
    bias = rel_bias.astype(jnp.float32)[:, jnp.clip(dist, -REL_CLIP, REL_CLIP) + REL_CLIP]
    valid = (jnp.arange(nc)[:, None] - ATT_PREV_CHUNKS + (kk // CHUNK)[None, :]) >= 0
    s = jnp.einsum('bnqhd,bnkhd->bnhqk', q, kb, preferred_element_type=jnp.float32) * HEAD_DIM ** -0.5 + bias[None, None]
    s = jnp.where(valid[None, :, None, None, :], s, -jnp.inf)
    p = jax.nn.softmax(s, axis=-1).astype(vb.dtype)
    o = jnp.einsum('bnhqk,bnkhd->bnqhd', p, vb)
    return o.reshape(B, S, BR_WIDTH)


def dsa_branch(qkv, qi, ki, wi, pos):
    B, S, _ = qkv.shape
    q, k, v = [t.reshape(B, S, BR_HEADS, HEAD_DIM) for t in jnp.split(qkv, 3, axis=-1)]
    q = rotary(q, pos)
    k = rotary(k, pos)
    qi = qi.reshape(B, S, IDX_HEADS, IDX_DIM)
    topk = min(DSA_TOPK_MAX, S // 4)
    nq = S // DSA_QBLOCK
    key_chunk = jnp.arange(S) // CHUNK

    def blocks(t):
        return jnp.swapaxes(t.reshape((B, nq, DSA_QBLOCK) + t.shape[2:]), 0, 1)

    def one_block(args):
        qb, qib, wib, n = args
        rel = jax.nn.relu(jnp.einsum('bqhd,bsd->bqhs', qib, ki, preferred_element_type=jnp.float32) * IDX_DIM ** -0.5)
        score = jnp.einsum('bqhs,bqh->bqs', rel, wib.astype(jnp.float32) * IDX_HEADS ** -0.5)
        score = jnp.where((key_chunk <= n)[None, None, :], score, -jnp.inf)
        _, idx = lax.top_k(score, topk)
        ks = jax.vmap(lambda kb_, ib: kb_[ib])(k, idx)
        vs = jax.vmap(lambda vb_, ib: vb_[ib])(v, idx)
        ok = key_chunk[idx] <= n
        s = jnp.einsum('bqhd,bqkhd->bhqk', qb, ks, preferred_element_type=jnp.float32) * HEAD_DIM ** -0.5
        s = jnp.where(ok[:, None], s, -jnp.inf)
        p = jax.nn.softmax(s, axis=-1).astype(vs.dtype)
        return jnp.einsum('bhqk,bqkhd->bqhd', p, vs)

    o = lax.map(one_block, (blocks(q), blocks(qi), blocks(wi), jnp.arange(nq)))
    return jnp.swapaxes(o, 0, 1).reshape(B, S, BR_WIDTH)


def hybrid_mixer(h, pos, w_in, conv_w, sg_norm_g, sg_w, sg_b, rel_bias, w_branch, w_o):
    B, S, D = h.shape
    a_in, b_in, c_in, d_qkv, d_qi, d_ki, d_wi, gate_logits = split_cols(h @ w_in, PROJ_SIZES)
    branches = (
        short_conv_branch(a_in, conv_w),
        spatial_gating_branch(b_in, sg_norm_g, sg_w, sg_b),
        chunk_band_attention(c_in, rel_bias),
        dsa_branch(d_qkv, d_qi, d_ki, d_wi, pos),
    )
    gates = jax.nn.sigmoid(gate_logits.astype(jnp.float32)).reshape(B, S, N_BRANCH, D)
    y = jnp.zeros((B, S, D), jnp.float32)
    for i, o in enumerate(branches):
        y = y + gates[:, :, i, :] * jnp.einsum('bsc,cd->bsd', o, w_branch[i], preferred_element_type=jnp.float32)
    return y.astype(h.dtype) @ w_o


def peer_ffn(h, wq, keys, u, v):
    B, S, D = h.shape
    T = B * S
    xt = h.reshape(T, D)
    q = (xt @ wq).reshape(T, PEER_HEADS, 2, PEER_HALF)
    s = jnp.einsum('thpd,hpkd->thpk', q, keys, preferred_element_type=jnp.float32)
    sv, si = lax.top_k(s, PEER_TOPK)
    cand = (sv[:, :, 0, :, None] + sv[:, :, 1, None, :]).reshape(T, PEER_HEADS, PEER_TOPK * PEER_TOPK)
    cidx = (si[:, :, 0, :, None] * PEER_NKEYS + si[:, :, 1, None, :]).reshape(T, PEER_HEADS, PEER_TOPK * PEER_TOPK)
    fv, fpos = lax.top_k(cand, PEER_TOPK)
    eidx = jnp.take_along_axis(cidx, fpos, axis=-1)
    g = jax.nn.softmax(fv, axis=-1)
    nb = T // PEER_TBLOCK
    E = PEER_HEADS * PEER_TOPK

    def one_block(args):
        xb, eb, gb = args
        a = jnp.einsum('td,ted->te', xb, u[eb], preferred_element_type=jnp.float32)
        hact = (jax.nn.gelu(a) * gb).astype(v.dtype)
        return jnp.einsum('te,ted->td', hact, v[eb])

    y = lax.map(one_block, (xt.reshape(nb, PEER_TBLOCK, D), eidx.reshape(nb, PEER_TBLOCK, E), g.reshape(nb, PEER_TBLOCK, E)))
    return y.reshape(B, S, D)


def setup_inputs(seed: int = 0) -> dict:
    key = jax.random.key(seed)
    ks = jax.random.split(key, 19)
    L = DEPTH
    D = D_MODEL

    def nrm(k, shape, scale):
        return jax.random.normal(k, shape, jnp.float32) * scale

    return {
        'x': nrm(ks[0], (BATCH, SEQ, D), 1.0),
        'c': nrm(ks[1], (BATCH, D), 1.0),
        'ada_w': nrm(ks[2], (L, D, 6 * D), 0.5 * D ** -0.5),
        'ada_b': nrm(ks[3], (L, 6 * D), 0.02),
        'norm1_g': 1.0 + nrm(ks[4], (L, D), 0.02),
        'norm2_g': 1.0 + nrm(ks[5], (L, D), 0.02),
        'w_in': nrm(ks[6], (L, D, P_IN), D ** -0.5),
        'conv_w': nrm(ks[7], (L, CONV_WIDTH, BR_WIDTH), CONV_WIDTH ** -0.5),
        'sg_norm_g': 1.0 + nrm(ks[8], (L, BR_WIDTH), 0.02),
        'sg_w': nrm(ks[9], (L, BR_HEADS, SG_BLOCK, SG_BLOCK), 0.5 * SG_BLOCK ** -0.5),
        'sg_b': 1.0 + nrm(ks[10], (L, BR_HEADS, SG_BLOCK), 0.02),
        'rel_bias': nrm(ks[11], (L, BR_HEADS, N_REL), 0.5),
        'w_branch': nrm(ks[12], (L, N_BRANCH, BR_WIDTH, D), BR_WIDTH ** -0.5),
        'w_o': nrm(ks[13], (L, D, D), D ** -0.5),
        'peer_wq': nrm(ks[14], (L, D, PEER_HEADS * PEER_QDIM), D ** -0.5),
        'peer_keys': nrm(ks[15], (L, PEER_HEADS, 2, PEER_NKEYS, PEER_HALF), PEER_HALF ** -0.5),
        'peer_u': nrm(ks[16], (L, PEER_EXPERTS, D), D ** -0.5),
        'peer_v': nrm(ks[17], (L, PEER_EXPERTS, D), 1.0),
        'final_g': 1.0 + nrm(ks[18], (D,), 0.02),
    }


def reference(x, c, ada_w, ada_b, norm1_g, norm2_g, w_in, conv_w, sg_norm_g, sg_w, sg_b, rel_bias, w_branch, w_o, peer_wq, peer_keys, peer_u, peer_v, final_g):
    S = x.shape[1]
    pos = jnp.arange(S, dtype=jnp.int32)
    c_act = jax.nn.silu(c)
    for l in range(DEPTH):
        mod = (c_act @ ada_w[l] + ada_b[l])[:, None, :]
        sh1, sc1, g1, sh2, sc2, g2 = jnp.split(mod, 6, axis=-1)
        hn = rms_norm(x, norm1_g[l]) * (1 + sc1) + sh1
        x = x + g1 * hybrid_mixer(hn, pos, w_in[l], conv_w[l], sg_norm_g[l], sg_w[l], sg_b[l], rel_bias[l], w_branch[l], w_o[l])
        hn = rms_norm(x, norm2_g[l]) * (1 + sc2) + sh2
        x = x + g2 * peer_ffn(hn, peer_wq[l], peer_keys[l], peer_u[l], peer_v[l])
    return rms_norm(x, final_g)
```

```cpp
#include <hip/hip_runtime.h>
#include <cstdint>
#include <cstdio>

#ifndef MK_ONE_LAUNCH
#define MK_ONE_LAUNCH 1
#endif
#ifndef PROBE_PHASE
#define PROBE_PHASE -1
#endif
#ifndef NAIVE_GEMM
#define NAIVE_GEMM 0
#endif

#define LAS __attribute__((address_space(3)))
#define GAS __attribute__((address_space(1)))
typedef unsigned short bf16;
typedef float f32x4 __attribute__((ext_vector_type(4)));
typedef float f32x2 __attribute__((ext_vector_type(2)));
typedef short bf16x8 __attribute__((ext_vector_type(8)));
typedef unsigned u32x4 __attribute__((ext_vector_type(4)));
typedef unsigned u32x2 __attribute__((ext_vector_type(2)));

constexpr int T = 16384, D = 2048, SEQ = 2048, NBATCH = 8, NLAYER = 2;
constexpr int PIN = 14928, NPROJ = 15104, NGATE = 8192;
constexpr int F8_LO = 5632, N8 = F8_LO + NGATE;
constexpr int BF_LO = 5632, NPROJ_BF = 1280;
constexpr int PIN_GATE0 = 6736;
constexpr int OFF_A = 0, OFF_SG = 1536, OFF_BAND = 2560, OFF_DSA = 4096, OFF_QI = 5632, OFF_KI = 6656, OFF_WI = 6720, OFF_GATE = 6912;
constexpr int BRW = 512;
constexpr float EPS = 1e-6f;
constexpr int NWAVES = 8, NTHR = 512;

constexpr size_t MiB = 1u << 20;
constexpr size_t WS_CTL = 0, CTL_ZERO_BYTES = 1 * MiB;
constexpr size_t WS_MOD = 1 * MiB;
constexpr size_t WS_ROPE = 2 * MiB;
constexpr size_t WS_WIN = 4 * MiB;
constexpr size_t WS_WB = 63 * MiB;
constexpr size_t WS_WO = 71 * MiB;
constexpr size_t WS_WQ = 79 * MiB;
constexpr size_t WS_KEYS = 87 * MiB;
constexpr size_t WS_U = 88 * MiB, WS_V = 152 * MiB;
constexpr size_t WS_SCL = 87 * MiB + 512 * 1024;
constexpr size_t WS_HN8 = 120 * MiB;
constexpr size_t WS_WG8 = 184 * MiB;
constexpr size_t WS_CSD = 87 * MiB + 704 * 1024;
constexpr size_t WS_RS = 87 * MiB + 640 * 1024;
constexpr size_t WS_CS = WS_CTL + 128 * 1024;
constexpr size_t WS_X = 216 * MiB;
constexpr size_t WS_HN = 344 * MiB;
constexpr size_t WS_OBR = 408 * MiB;
constexpr size_t WS_Y = 472 * MiB;
constexpr size_t WS_MASK = 536 * MiB;
constexpr size_t WS_EIDX = 540 * MiB, WS_GW = 548 * MiB;
constexpr size_t WS_PROJ = 556 * MiB;
constexpr size_t WS_QP = WS_PROJ;
constexpr size_t WS_YP = WS_PROJ + 64 * MiB;
constexpr size_t WS_QV = WS_CTL + 384 * 1024;
constexpr size_t WS_SC = WS_PROJ + 64 * MiB;
constexpr size_t WS_SCI = WS_PROJ + 192 * MiB;
constexpr size_t WS_END = 1028 * MiB;
constexpr int CW_BAR = 4096;

constexpr int RING_BYTES = 131072;
constexpr int LDS_BYTES = 163840;
constexpr int LDSCTL_OFF = LDS_BYTES - 256;

__device__ __forceinline__ float bf2f(bf16 b) { return __uint_as_float(((unsigned)b) << 16); }
__device__ __forceinline__ unsigned f2bf(float f) { unsigned u = __float_as_uint(f); return (u + 0x7fffu + ((u >> 16) & 1u)) >> 16; }
__device__ __forceinline__ unsigned pk2(float lo, float hi) { return f2bf(lo) | (f2bf(hi) << 16); }
__device__ __forceinline__ float bflo(unsigned w) { return __uint_as_float(w << 16); }
__device__ __forceinline__ float bfhi(unsigned w) { return __uint_as_float(w & 0xffff0000u); }
#define DPP_ADD(v, ctl, rmask, bc) (v) += __builtin_bit_cast(float, __builtin_amdgcn_update_dpp(0, __builtin_bit_cast(int, (v)), (ctl), (rmask), 0xf, (bc)))
__device__ __forceinline__ float wave_total(float v) {
    DPP_ADD(v, 0x111, 0xf, true); DPP_ADD(v, 0x112, 0xf, true); DPP_ADD(v, 0x114, 0xf, true); DPP_ADD(v, 0x118, 0xf, true);
    DPP_ADD(v, 0x142, 0xa, false); DPP_ADD(v, 0x143, 0xc, false);
    return __builtin_bit_cast(float, __builtin_amdgcn_readlane(__builtin_bit_cast(int, v), 63));
}
__device__ __forceinline__ float wave_sum(float v) { return wave_total(v); }
#define DPP_MAX(v, ctl, rmask, bc) (v) = fmaxf((v), __builtin_bit_cast(float, __builtin_amdgcn_update_dpp(0, __builtin_bit_cast(int, (v)), (ctl), (rmask), 0xf, (bc))))
__device__ __forceinline__ float wave_amax(float v) {
    DPP_MAX(v, 0x111, 0xf, true); DPP_MAX(v, 0x112, 0xf, true); DPP_MAX(v, 0x114, 0xf, true); DPP_MAX(v, 0x118, 0xf, true);
    DPP_MAX(v, 0x142, 0xa, false); DPP_MAX(v, 0x143, 0xc, false);
    return __builtin_bit_cast(float, __builtin_amdgcn_readlane(__builtin_bit_cast(int, v), 63));
}
__device__ __forceinline__ float wave_max(float v) {
#pragma unroll
    for (int o = 1; o < 64; o <<= 1) v = fmaxf(v, __shfl_xor(v, o));
    return v;
}
#define LDS_WAIT() asm volatile("s_waitcnt lgkmcnt(0)" ::: "memory")

__host__ __device__ __forceinline__ int win_src_col(int j) {
    if (j < 4096) return j;
    if (j < 5120) { const int base = j & ~127, p = j & 127; return base + ((p & 1) ? 64 + (p >> 1) : (p >> 1)); }
    if (j < 6736) return j;
    if (j < OFF_GATE) return -1;
    return j - (OFF_GATE - 6736);
}


__host__ __device__ __forceinline__ int f8_src_col(int j8) {
    if (j8 < F8_LO) return win_src_col(j8);
    const int g = j8 - F8_LO, j = g >> 8, c = g & 255, br = 2 * (c >> 7) + ((c >> 2) & 1), ch = 64 * j + 16 * ((c >> 5) & 3) + 4 * ((c >> 3) & 3) + (c & 3);
    return PIN_GATE0 + br * D + ch;
}

namespace pg8 {
#define PG8_LAS __attribute__((address_space(3)))
typedef unsigned short bf16_t;
constexpr int BM = 256, BK = 64, HALF = 128, HTB = HALF * BK * 2, STAGE_BYTES = 8 * HTB, NXCD = 8, WGM = 2;
__host__ __device__ __forceinline__ int lds_byte(int r, int c) { const int st = (r >> 4) * 2 + (c >> 5), rr = r & 15, cc = c & 31, ob = rr * 64 + cc * 2; return st * 1024 + (ob ^ (((ob >> 9) & 1) << 5)); }
__host__ __device__ __forceinline__ void stage_rc(int b, int& R, int& C) { const int st = b / 1024, sb = b % 1024, swz = sb ^ (((sb >> 9) & 1) << 5); R = (st >> 1) * 16 + swz / 64; C = (st & 1) * 32 + (swz % 64) / 2; }
__host__ __device__ __forceinline__ int perm32(int rho) { const int n = rho >> 4, i = rho & 15; return 8 * (i >> 2) + 4 * n + (i & 3); }

struct Unit { int pm, pn, pz; };
struct Gemm { const bf16_t* A; const bf16_t* Bt; int M, N, K; size_t zA, zB; };

struct StaticOrder {
    int nM, nN, nwg, G, c;
    __host__ __device__ void init(int M, int N, int G_, int c_) { nM = M / BM; nN = N / BM; nwg = nM * nN; G = G_; c = c_; }
    __host__ __device__ bool next(int i, Unit& u) const {
        const long L = (long)i * G + c; if (L >= nwg) return false;
        int wgid = (int)L; { const int q = nwg / NXCD, r = nwg % NXCD, xcd = wgid % NXCD, off = wgid / NXCD; wgid = (xcd < r ? xcd * (q + 1) : r * (q + 1) + (xcd - r) * q) + off; }
        const int nig = WGM * nN, gid = wgid / nig, fm = gid * WGM, gsz = (nM - fm) < WGM ? (nM - fm) : WGM;
        u.pm = fm + ((wgid % nig) % gsz); u.pn = (wgid % nig) / gsz; u.pz = 0; return true;
    }
    __device__ __forceinline__ void a_ready(const Unit&) const {}
    __device__ __forceinline__ void done(const Unit&) const {}
};
struct F8BalOrder {
    StaticOrder so; int c;
    __device__ __forceinline__ bool next(int i, Unit& u) const {
        if (so.G != 256 || so.nwg != 3456) return so.next(i, u);
        long L; if (i < 12) L = (long)i * 256 + c; else if (c >= 64 && i < 14) L = 3072 + (long)(i - 12) * 192 + (c - 64); else return false;
        StaticOrder t = so; t.G = 1; t.c = 0; return t.next((int)L, u);
    }
    __device__ __forceinline__ void a_ready(const Unit&) const {}
    __device__ __forceinline__ void done(const Unit&) const {}
};
template <int NZ> struct BatchOrder {
    StaticOrder so;
    __device__ __forceinline__ bool next(int i, Unit& u) const { if (!so.next(i / NZ, u)) return false; u.pz = i % NZ; return true; }
    __device__ __forceinline__ void a_ready(const Unit&) const {}
    __device__ __forceinline__ void done(const Unit&) const {}
};

typedef __bf16 bf16x2_t __attribute__((ext_vector_type(2)));
__device__ __forceinline__ unsigned cvt_pk_bf16(float lo, float hi) { const f32x2 v = {lo, hi}; return __builtin_bit_cast(unsigned, __builtin_convertvector(v, bf16x2_t)); }

typedef int v8i_t __attribute__((ext_vector_type(8)));
__device__ __forceinline__ v8i_t cat8(bf16x8 lo, bf16x8 hi) { const u32x4 a = __builtin_bit_cast(u32x4, lo), b = __builtin_bit_cast(u32x4, hi); return (v8i_t){(int)a.x, (int)a.y, (int)a.z, (int)a.w, (int)b.x, (int)b.y, (int)b.z, (int)b.w}; }
template <class Epi, class Sched, bool ALIGN_EPI = false, bool SP2 = false, bool F8 = false>
__device__ __forceinline__ void gemm_phase(PG8_LAS unsigned char* lds, const Gemm g, const Sched& S, const Epi& E) {
    int tid_ = threadIdx.x; asm volatile("" : "+v"(tid_));
    const int tid = tid_, wid = __builtin_amdgcn_readfirstlane(tid >> 6), lane = tid & 63, wr = wid >> 2, wc = wid & 3, fr = lane & 15, fq = lane >> 4;
    constexpr int EB = F8 ? 1 : 2;
    const int K = g.K, nt = K * EB / (BK * 2);
    unsigned voffA[2], voffB[2];
#pragma unroll
    for (int i = 0; i < 2; ++i) { int R, C; stage_rc(tid * 16 + i * 8192, R, C); const int Rb = Epi::PERM ? ((R & ~31) + perm32(R & 31)) : R;
        voffA[i] = (unsigned)(R * K * EB + C * 2); voffB[i] = (unsigned)(Rb * K * EB + C * 2); }
    const size_t kstep = (size_t)(BK * 2);
    const size_t hstep = (size_t)HALF * K * EB;
    const size_t tstep = 2 * hstep;
    const unsigned ldsw = (unsigned)wid * 1024u;
    const int aoff = lds_byte(wr * 64 + fr, fq * 8), boff = lds_byte(wc * 32 + fr, fq * 8);
#define PG8_SA(b, h) (((b) * 2 + (h)) * HTB)
#define PG8_SB(b, h) ((4 + (b) * 2 + (h)) * HTB)
#define PG8_STAGE(bufoff, gbase, voff) do { _Pragma("unroll") for (int _i = 0; _i < 2; ++_i) \
        __builtin_amdgcn_global_load_lds((const unsigned*)((const char*)(gbase) + (voff)[_i]), (PG8_LAS unsigned*)(lds + (bufoff) + ldsw + _i * 8192), 16, 0, 0); } while (0)
#define PG8_LDA(dst, b, h) do { if constexpr (F8) { _Pragma("unroll") for (int m = 0; m < 4; ++m) { const u32x4 _lo = *(const PG8_LAS u32x4*)(lds + PG8_SA(b, h) + aoff + m * 2048), _hi = *(const PG8_LAS u32x4*)(lds + PG8_SA(b, h) + aoff + m * 2048 + 1024); \
            dst##8[m] = (v8i_t){(int)_lo.x, (int)_lo.y, (int)_lo.z, (int)_lo.w, (int)_hi.x, (int)_hi.y, (int)_hi.z, (int)_hi.w}; } } \
        else { _Pragma("unroll") for (int m = 0; m < 4; ++m) _Pragma("unroll") for (int k = 0; k < 2; ++k) dst[m][k] = *(const PG8_LAS bf16x8*)(lds + PG8_SA(b, h) + aoff + m * 2048 + k * 1024); } } while (0)
#define PG8_LDB(dst, b, h) do { if constexpr (F8) { _Pragma("unroll") for (int n = 0; n < 2; ++n) { const u32x4 _lo = *(const PG8_LAS u32x4*)(lds + PG8_SB(b, h) + boff + n * 2048), _hi = *(const PG8_LAS u32x4*)(lds + PG8_SB(b, h) + boff + n * 2048 + 1024); \
            dst##8[n] = (v8i_t){(int)_lo.x, (int)_lo.y, (int)_lo.z, (int)_lo.w, (int)_hi.x, (int)_hi.y, (int)_hi.z, (int)_hi.w}; } } \
        else { _Pragma("unroll") for (int n = 0; n < 2; ++n) _Pragma("unroll") for (int k = 0; k < 2; ++k) dst[n][k] = *(const PG8_LAS bf16x8*)(lds + PG8_SB(b, h) + boff + n * 2048 + k * 1024); } } while (0)
#define PG8_MMA(ai, bj, At, Bt) do { __builtin_amdgcn_s_setprio(1); \
        if constexpr (F8) { _Pragma("unroll") for (int m = 0; m < 4; ++m) _Pragma("unroll") for (int n = 0; n < 2; ++n) \
            asm volatile("s_nop 1\n\tv_mfma_scale_f32_16x16x128_f8f6f4 %0, %1, %2, %0, %3, %3 op_sel_hi:[0,0,0]" : "+v"(acc[ai][bj][m][n]) : "v"(Bt##8[n]), "v"(At##8[m]), "v"(mxs)); } \
        else { _Pragma("unroll") for (int m = 0; m < 4; ++m) _Pragma("unroll") for (int n = 0; n < 2; ++n) _Pragma("unroll") for (int k = 0; k < 2; ++k) \
            acc[ai][bj][m][n] = __builtin_amdgcn_mfma_f32_16x16x32_bf16(Bt[n][k], At[m][k], acc[ai][bj][m][n], 0, 0, 0); } \
        __builtin_amdgcn_s_setprio(0); } while (0)
#define PG8_WAIT_V(n) asm volatile("s_waitcnt vmcnt(" #n ")" ::: "memory")
#define PG8_WAIT_L(n) asm volatile("s_waitcnt lgkmcnt(" #n ")" ::: "memory")
#define PG8_BAR __builtin_amdgcn_s_barrier()
#define PG8_SCHED __builtin_amdgcn_sched_barrier(0)
    Unit cur, nxt; int ui = 0;
    if (!S.next(0, cur)) return;
    f32x4 acc[2][2][4][2];
#pragma unroll
    for (int a = 0; a < 2; ++a)
#pragma unroll
        for (int b = 0; b < 2; ++b)
#pragma unroll
            for (int m = 0; m < 4; ++m)
#pragma unroll
                for (int n = 0; n < 2; ++n) acc[a][b][m][n] = (f32x4){0.f, 0.f, 0.f, 0.f};
    const int mxs = 0x7f7f7f7f;
    bf16x8 At[4][2], B0[2][2], B1[2][2]; v8i_t At8[4], B08[2], B18[2];
    const char* cA = (const char*)g.A + (size_t)cur.pm * tstep + (size_t)cur.pz * g.zA; const char* cB = (const char*)g.Bt + (size_t)cur.pn * tstep + (size_t)cur.pz * g.zB;
    S.a_ready(cur);
    if constexpr (SP2) {
        PG8_STAGE(PG8_SB(0, 0), cB, voffB); PG8_STAGE(PG8_SB(0, 1), cB + hstep, voffB); PG8_STAGE(PG8_SA(0, 0), cA, voffA); PG8_STAGE(PG8_SA(0, 1), cA + hstep, voffA);
        if (wr == 1) PG8_BAR;
        PG8_WAIT_V(2); PG8_BAR;
        PG8_STAGE(PG8_SB(1, 0), cB + kstep, voffB); PG8_STAGE(PG8_SA(1, 0), cA + kstep, voffA); PG8_STAGE(PG8_SB(1, 1), cB + hstep + kstep, voffB);
        PG8_WAIT_V(6); PG8_BAR;
    } else {
        PG8_STAGE(PG8_SB(0, 0), cB, voffB); PG8_STAGE(PG8_SA(0, 0), cA, voffA); PG8_STAGE(PG8_SB(0, 1), cB + hstep, voffB); PG8_STAGE(PG8_SA(0, 1), cA + hstep, voffA);
        if (wr == 1) PG8_BAR;
        PG8_WAIT_V(4); PG8_BAR;
        PG8_STAGE(PG8_SB(1, 0), cB + kstep, voffB); PG8_STAGE(PG8_SA(1, 0), cA + kstep, voffA); PG8_STAGE(PG8_SB(1, 1), cB + hstep + kstep, voffB);
        PG8_WAIT_V(6); PG8_BAR;
    }
    for (;;) {
        const bool has_next = S.next(ui + 1, nxt);
        const char* nA = has_next ? (const char*)g.A + (size_t)nxt.pm * tstep + (size_t)nxt.pz * g.zA : cA; const char* nB = has_next ? (const char*)g.Bt + (size_t)nxt.pn * tstep + (size_t)nxt.pz * g.zB : cB;
        for (int t = 0; t < nt; t += 2) {
            const bool last = (t == nt - 2);
            const char* a1 = cA + (size_t)(t + 1) * kstep;
            const char* a2 = last ? nA : cA + (size_t)(t + 2) * kstep; const char* b2 = last ? nB : cB + (size_t)(t + 2) * kstep;
            const char* a3 = a2 + kstep; const char* b3 = b2 + kstep;
            if (last && has_next) S.a_ready(nxt);
            if constexpr (SP2) {
            PG8_LDB(B0, 0, 0); PG8_LDB(B1, 0, 1); PG8_SCHED; PG8_LDA(At, 0, 0); PG8_STAGE(PG8_SA(1, 1), a1 + hstep, voffA);
            PG8_WAIT_V(8); PG8_WAIT_L(0); PG8_BAR; PG8_MMA(0, 0, At, B0); PG8_MMA(0, 1, At, B1); PG8_BAR; PG8_SCHED;
            PG8_LDA(At, 0, 1); PG8_STAGE(PG8_SB(0, 0), b2, voffB); PG8_STAGE(PG8_SB(0, 1), b2 + hstep, voffB); PG8_STAGE(PG8_SA(0, 0), a2, voffA);
            PG8_WAIT_V(8); PG8_WAIT_L(0); PG8_BAR; PG8_MMA(1, 0, At, B0); PG8_MMA(1, 1, At, B1); PG8_BAR; PG8_SCHED;
            PG8_LDB(B0, 1, 0); PG8_LDB(B1, 1, 1); PG8_SCHED; PG8_LDA(At, 1, 0); PG8_STAGE(PG8_SA(0, 1), a2 + hstep, voffA);
            PG8_WAIT_V(8); PG8_WAIT_L(0); PG8_BAR; PG8_MMA(0, 0, At, B0); PG8_MMA(0, 1, At, B1); PG8_BAR; PG8_SCHED;
            PG8_LDA(At, 1, 1); PG8_STAGE(PG8_SB(1, 0), b3, voffB); PG8_STAGE(PG8_SB(1, 1), b3 + hstep, voffB); PG8_STAGE(PG8_SA(1, 0), a3, voffA);
            PG8_WAIT_V(8); PG8_WAIT_L(0); PG8_BAR; PG8_MMA(1, 0, At, B0); PG8_MMA(1, 1, At, B1); PG8_BAR; PG8_SCHED;
            } else {
            PG8_LDB(B0, 0, 0); PG8_SCHED; PG8_LDA(At, 0, 0); PG8_STAGE(PG8_SA(1, 1), a1 + hstep, voffA);
            PG8_WAIT_L(8); PG8_BAR; PG8_WAIT_L(0); PG8_MMA(0, 0, At, B0); PG8_BAR; PG8_SCHED;
            PG8_LDB(B1, 0, 1); PG8_STAGE(PG8_SB(0, 0), b2, voffB);
            PG8_BAR; PG8_WAIT_L(0); PG8_MMA(0, 1, At, B1); PG8_BAR;
            PG8_LDA(At, 0, 1); PG8_STAGE(PG8_SA(0, 0), a2, voffA);
            PG8_BAR; PG8_WAIT_L(0); PG8_MMA(1, 0, At, B0); PG8_BAR; PG8_SCHED;
            PG8_STAGE(PG8_SB(0, 1), b2 + hstep, voffB);
            PG8_WAIT_V(6); PG8_BAR; PG8_MMA(1, 1, At, B1); PG8_BAR;
            PG8_LDB(B0, 1, 0); PG8_SCHED; PG8_LDA(At, 1, 0); PG8_STAGE(PG8_SA(0, 1), a2 + hstep, voffA);
            PG8_WAIT_L(8); PG8_BAR; PG8_WAIT_L(0); PG8_MMA(0, 0, At, B0); PG8_BAR; PG8_SCHED;
            PG8_LDB(B1, 1, 1); PG8_STAGE(PG8_SB(1, 0), b3, voffB);
            PG8_BAR; PG8_WAIT_L(0); PG8_MMA(0, 1, At, B1); PG8_BAR;
            PG8_LDA(At, 1, 1); PG8_STAGE(PG8_SA(1, 0), a3, voffA);
            PG8_BAR; PG8_WAIT_L(0); PG8_MMA(1, 0, At, B0); PG8_BAR; PG8_SCHED;
            PG8_STAGE(PG8_SB(1, 1), b3 + hstep, voffB);
            PG8_WAIT_V(6); PG8_BAR; PG8_MMA(1, 1, At, B1); PG8_BAR;
            }
        }
        if constexpr (ALIGN_EPI) { if (wr == 0) PG8_BAR; }
        if constexpr (F8) { asm volatile("s_nop 15\n\ts_nop 15" ::: "memory");
#pragma unroll
            for (int a = 0; a < 2; ++a)
#pragma unroll
                for (int b = 0; b < 2; ++b)
#pragma unroll
                    for (int m = 0; m < 4; ++m)
#pragma unroll
                        for (int n = 0; n < 2; ++n) asm volatile("" : "+v"(acc[a][b][m][n])); }
        E(acc, cur, wr, wc, fr, fq); S.done(cur);
        if (!has_next) break;
        if (!Epi::CHAIN || nxt.pz == 0) {
#pragma unroll
        for (int a = 0; a < 2; ++a)
#pragma unroll
            for (int b = 0; b < 2; ++b)
#pragma unroll
                for (int m = 0; m < 4; ++m)
#pragma unroll
                    for (int n = 0; n < 2; ++n) acc[a][b][m][n] = (f32x4){0.f, 0.f, 0.f, 0.f};
        }
        cur = nxt; cA = nA; cB = nB; ++ui;
        if constexpr (ALIGN_EPI) { if (wr == 1) PG8_BAR; }
    }
    PG8_WAIT_V(0);
    if constexpr (!ALIGN_EPI) { if (wr == 0) PG8_BAR; }
    PG8_BAR;
#undef PG8_SA
#undef PG8_SB
#undef PG8_STAGE
#undef PG8_LDA
#undef PG8_LDB
#undef PG8_MMA
#undef PG8_WAIT_V
#undef PG8_WAIT_L
#undef PG8_BAR
#undef PG8_SCHED
}

__device__ __forceinline__ float sigm(float v) { return __builtin_amdgcn_rcpf(1.0f + __expf(-v)); }

struct EpiProj {
    static constexpr bool PERM = true; static constexpr bool CHAIN = false;
    bf16_t* O; const float* rope;
    __device__ __forceinline__ void operator()(const f32x4 (&acc)[2][2][4][2], const Unit& u, int wr, int wc, int fr, int fq) const {
        const int row0 = u.pm * BM + wr * 64 + fr, col0 = u.pn * BM + wc * 32 + 8 * fq;
        const int mode = (u.pn >= 27) ? 2 : ((u.pn >= 16 && u.pn < 20) ? 1 : 0);
        const int ip = 16 * wc + 4 * fq;
#pragma unroll
        for (int ai = 0; ai < 2; ++ai)
#pragma unroll
            for (int m = 0; m < 4; ++m) { const int row = row0 + ai * HALF + m * 16; bf16_t* rowp = O + (size_t)row * NPROJ + col0;
                f32x4 r0 = (f32x4){1.f, 0.f, 1.f, 0.f}, r1 = r0;
                if (mode == 1) { const f32x4* rp = (const f32x4*)(rope + ((size_t)(row & (SEQ - 1)) * 64 + ip) * 2); r0 = rp[0]; r1 = rp[1]; }
#pragma unroll
                for (int bj = 0; bj < 2; ++bj) { f32x4 v0 = acc[ai][bj][m][0], v1 = acc[ai][bj][m][1];
                    if (mode == 2) { v0 = (f32x4){sigm(v0[0]), sigm(v0[1]), sigm(v0[2]), sigm(v0[3])}; v1 = (f32x4){sigm(v1[0]), sigm(v1[1]), sigm(v1[2]), sigm(v1[3])}; }
                    else if (mode == 1) {
                        v0 = (f32x4){v0[0] * r0[0] - v0[1] * r0[1], v0[1] * r0[0] + v0[0] * r0[1], v0[2] * r0[2] - v0[3] * r0[3], v0[3] * r0[2] + v0[2] * r0[3]};
                        v1 = (f32x4){v1[0] * r1[0] - v1[1] * r1[1], v1[1] * r1[0] + v1[0] * r1[1], v1[2] * r1[2] - v1[3] * r1[3], v1[3] * r1[2] + v1[2] * r1[3]}; }
                    u32x4 w; w.x = cvt_pk_bf16(v0[0], v0[1]); w.y = cvt_pk_bf16(v0[2], v0[3]); w.z = cvt_pk_bf16(v1[0], v1[1]); w.w = cvt_pk_bf16(v1[2], v1[3]);
                    *(u32x4*)(rowp + bj * HALF) = w; } }
    }
};
struct EpiF8 {
    static constexpr bool PERM = true; static constexpr bool CHAIN = false;
    bf16_t* O; const float* rs; const float* cs; const float* rope;
    __device__ __forceinline__ void operator()(const f32x4 (&acc)[2][2][4][2], const Unit& u, int wr, int wc, int fr, int fq) const {
        const int row0 = u.pm * BM + wr * 64 + fr, col8 = u.pn * BM + wc * 32 + 8 * fq;
        const int colp = u.pn * BM + wc * 32 + 8 * fq;
        const int mode = (u.pn >= 22) ? 2 : ((u.pn >= 16 && u.pn < 20) ? 1 : 0);
        const int ip = 16 * wc + 4 * fq;
        float rr[2][4]; f32x4 cc[2][2];
#pragma unroll
        for (int ai = 0; ai < 2; ++ai)
#pragma unroll
            for (int m = 0; m < 4; ++m) rr[ai][m] = rs[row0 + ai * HALF + m * 16];
#pragma unroll
        for (int bj = 0; bj < 2; ++bj) { cc[bj][0] = *(const f32x4*)(cs + col8 + bj * HALF); cc[bj][1] = *(const f32x4*)(cs + col8 + bj * HALF + 4); }
        if (mode == 2) {
            const int chan = OFF_GATE + (u.pn - 22) * 64 + wc * 16 + 4 * (fq & ~1) + (fq & 1) * 2 * D;
#pragma unroll
            for (int ai = 0; ai < 2; ++ai)
#pragma unroll
                for (int m = 0; m < 4; ++m) { const int row = row0 + ai * HALF + m * 16; const float r = rr[ai][m]; bf16_t* rowp = O + (size_t)row * NPROJ + chan;
                    f32x4 e[4], gi[4];
#pragma unroll
                    for (int b = 0; b < 4; ++b) { const f32x4 v = acc[ai][b >> 1][m][b & 1] * cc[b >> 1][b & 1] * r;
#pragma unroll
                        for (int q = 0; q < 4; ++q) { e[b][q] = 1.0f + __expf(-fminf(fmaxf(v[q], -30.0f), 30.0f)); gi[b][q] = __builtin_amdgcn_rcpf(e[b][q]); } }
                    u32x2 pw[4];
#pragma unroll
                    for (int k = 0; k < 4; ++k) { const f32x4 o = (k < 3) ? gi[k] * e[(k + 1) & 3] : gi[3]; pw[k].x = cvt_pk_bf16(o[0], o[1]); pw[k].y = cvt_pk_bf16(o[2], o[3]); }
#pragma unroll
                    for (int k = 0; k < 2; ++k) {
                        const u32x2 sa = __builtin_amdgcn_permlane16_swap(pw[k].x, pw[k + 2].x, false, false), sb = __builtin_amdgcn_permlane16_swap(pw[k].y, pw[k + 2].y, false, false);
                        u32x4 w; w.x = sa.x; w.y = sb.x; w.z = sa.y; w.w = sb.y; *(u32x4*)(rowp + k * D) = w; } }
            return;
        }
#pragma unroll
        for (int ai = 0; ai < 2; ++ai)
#pragma unroll
            for (int m = 0; m < 4; ++m) { const int row = row0 + ai * HALF + m * 16; const float r = rr[ai][m]; bf16_t* rowp = O + (size_t)row * NPROJ + colp;
                f32x4 r0 = (f32x4){1.f, 0.f, 1.f, 0.f}, r1 = r0;
                if (mode == 1) { const f32x4* rp = (const f32x4*)(rope + ((size_t)(row & (SEQ - 1)) * 64 + ip) * 2); r0 = rp[0]; r1 = rp[1]; }
#pragma unroll
                for (int bj = 0; bj < 2; ++bj) { const f32x4 c0 = cc[bj][0], c1 = cc[bj][1];
                    f32x4 v0 = acc[ai][bj][m][0] * c0 * r, v1 = acc[ai][bj][m][1] * c1 * r;
                    if (mode == 1) {
                        v0 = (f32x4){v0[0] * r0[0] - v0[1] * r0[1], v0[1] * r0[0] + v0[0] * r0[1], v0[2] * r0[2] - v0[3] * r0[3], v0[3] * r0[2] + v0[2] * r0[3]};
                        v1 = (f32x4){v1[0] * r1[0] - v1[1] * r1[1], v1[1] * r1[0] + v1[0] * r1[1], v1[2] * r1[2] - v1[3] * r1[3], v1[3] * r1[2] + v1[2] * r1[3]}; }
                    u32x4 w; w.x = cvt_pk_bf16(v0[0], v0[1]); w.y = cvt_pk_bf16(v0[2], v0[3]); w.z = cvt_pk_bf16(v1[0], v1[1]); w.w = cvt_pk_bf16(v1[2], v1[3]);
                    *(u32x4*)(rowp + bj * HALF) = w; } }
    }
};
struct EpiBf16 {
    static constexpr bool PERM = true; static constexpr bool CHAIN = false;
    bf16_t* O; int ldc;
    __device__ __forceinline__ void operator()(const f32x4 (&acc)[2][2][4][2], const Unit& u, int wr, int wc, int fr, int fq) const {
        const int row0 = u.pm * BM + wr * 64 + fr, col0 = u.pn * BM + wc * 32 + 8 * fq;
#pragma unroll
        for (int ai = 0; ai < 2; ++ai)
#pragma unroll
            for (int m = 0; m < 4; ++m) { bf16_t* rowp = O + (size_t)(row0 + ai * HALF + m * 16) * ldc + col0;
#pragma unroll
                for (int bj = 0; bj < 2; ++bj) { const f32x4 v0 = acc[ai][bj][m][0], v1 = acc[ai][bj][m][1];
                    u32x4 w; w.x = cvt_pk_bf16(v0[0], v0[1]); w.y = cvt_pk_bf16(v0[2], v0[3]); w.z = cvt_pk_bf16(v1[0], v1[1]); w.w = cvt_pk_bf16(v1[2], v1[3]);
                    *(u32x4*)(rowp + bj * HALF) = w; } }
    }
};
struct EpiBranch {
    static constexpr bool PERM = true; static constexpr bool CHAIN = true;
    bf16_t* Y; const bf16_t* proj;
    __device__ __forceinline__ void operator()(f32x4 (&acc)[2][2][4][2], const Unit& u, int wr, int wc, int fr, int fq) const {
        const int row0 = u.pm * BM + wr * 64 + fr, col0 = u.pn * BM + wc * 32 + 8 * fq;
        u32x4 gw[2][4][2];
#pragma unroll
        for (int ai = 0; ai < 2; ++ai)
#pragma unroll
            for (int m = 0; m < 4; ++m)
#pragma unroll
                for (int bj = 0; bj < 2; ++bj) gw[ai][m][bj] = *(const u32x4*)(proj + (size_t)(row0 + ai * HALF + m * 16) * NPROJ + OFF_GATE + u.pz * D + col0 + bj * HALF);
#pragma unroll
        for (int ai = 0; ai < 2; ++ai)
#pragma unroll
            for (int m = 0; m < 4; ++m)
#pragma unroll
                for (int bj = 0; bj < 2; ++bj) { const u32x4 g = gw[ai][m][bj];
                    acc[ai][bj][m][0] = acc[ai][bj][m][0] * (f32x4){bflo(g.x), bfhi(g.x), bflo(g.y), bfhi(g.y)};
                    acc[ai][bj][m][1] = acc[ai][bj][m][1] * (f32x4){bflo(g.z), bfhi(g.z), bflo(g.w), bfhi(g.w)}; }
        if (u.pz == 3) {
#pragma unroll
            for (int ai = 0; ai < 2; ++ai)
#pragma unroll
                for (int m = 0; m < 4; ++m) { bf16_t* yp = Y + (size_t)(row0 + ai * HALF + m * 16) * D + col0;
#pragma unroll
                    for (int bj = 0; bj < 2; ++bj) { const f32x4 v0 = acc[ai][bj][m][0], v1 = acc[ai][bj][m][1];
                        u32x4 w; w.x = cvt_pk_bf16(v0[0], v0[1]); w.y = cvt_pk_bf16(v0[2], v0[3]); w.z = cvt_pk_bf16(v1[0], v1[1]); w.w = cvt_pk_bf16(v1[2], v1[3]);
                        *(u32x4*)(yp + bj * HALF) = w; } }
        }
    }
};
struct EpiResid {
    static constexpr bool PERM = false; static constexpr bool CHAIN = false;
    const float* xin; float* xout; const float* gate;
    __device__ __forceinline__ void operator()(const f32x4 (&acc)[2][2][4][2], const Unit& u, int wr, int wc, int fr, int fq) const {
        const int row0 = u.pm * BM + wr * 64 + fr, col0 = u.pn * BM + wc * 32 + 4 * fq;
        const float* gb = gate + (size_t)((u.pm * BM) >> 11) * 12288 + col0;
        f32x4 gv[2][2];
#pragma unroll
        for (int bj = 0; bj < 2; ++bj)
#pragma unroll
            for (int n = 0; n < 2; ++n) gv[bj][n] = *(const f32x4*)(gb + bj * HALF + n * 16);
#pragma unroll
        for (int ai = 0; ai < 2; ++ai) {
            f32x4 xi[4][2][2];
#pragma unroll
            for (int m = 0; m < 4; ++m)
#pragma unroll
                for (int bj = 0; bj < 2; ++bj)
#pragma unroll
                    for (int n = 0; n < 2; ++n) xi[m][bj][n] = *(const f32x4*)(xin + (size_t)(row0 + ai * HALF + m * 16) * D + col0 + bj * HALF + n * 16);
#pragma unroll
            for (int m = 0; m < 4; ++m)
#pragma unroll
                for (int bj = 0; bj < 2; ++bj)
#pragma unroll
                    for (int n = 0; n < 2; ++n) *(f32x4*)(xout + (size_t)(row0 + ai * HALF + m * 16) * D + col0 + bj * HALF + n * 16) = xi[m][bj][n] + gv[bj][n] * acc[ai][bj][m][n];
        }
    }
};
}

#define XB_TMO      128
#define XB_XCNT(j)  (256  + 64 * (j))
#define XB_XSUB(j)  (1280 + 64 * (j))
#define XB_XGEN(j)  (2304 + 64 * (j))
#define XB_TOP      3328
#define XB_TOPGEN   3392
#define XCD_BAR_WORDS 3456
#define XB_SPIN_CAP (1u << 18)
__device__ __forceinline__ unsigned xb_ld(unsigned* p)              { return __hip_atomic_load(p, __ATOMIC_RELAXED, __HIP_MEMORY_SCOPE_AGENT); }
__device__ __forceinline__ unsigned xb_add(unsigned* p, unsigned v) { return __hip_atomic_fetch_add(p, v, __ATOMIC_RELAXED, __HIP_MEMORY_SCOPE_AGENT); }
__device__ __forceinline__ unsigned xb_xcc_id() { return (unsigned)__builtin_amdgcn_s_getreg((3 << 11) | 20) & 0xFu; }
#define XB_SPIN(cond, bar) do { unsigned _sp = 0; while (cond) { __builtin_amdgcn_s_sleep(1); \
    if ((++_sp & 255u) == 0u) { if (xb_ld(&(bar)[XB_TMO])) break; if (_sp > XB_SPIN_CAP) { atomicAdd(&(bar)[XB_TMO], 1u); break; } } } } while (0)
struct XcdBarrier { unsigned* bar; unsigned x; volatile LAS unsigned* st; };
__device__ __forceinline__ XcdBarrier xcd_barrier_post(unsigned* bar, volatile LAS unsigned* st) {
    XcdBarrier b; b.bar = bar; b.x = xb_xcc_id(); b.st = st;
    if (threadIdx.x == 0) (void)xb_add(&bar[XB_XCNT(b.x)], 1u);
    return b;
}
__device__ __forceinline__ void xcd_barrier_complete(unsigned* bar, unsigned x, unsigned& nloc, unsigned& nx) {
    const unsigned G = gridDim.x * gridDim.y * gridDim.z;
    unsigned sum, cnt, mine, sp = 0u;
    for (;;) {
        sum = 0u; cnt = 0u; mine = 0u;
#pragma unroll
        for (unsigned j = 0; j < 16; ++j) { const unsigned c = xb_ld(&bar[XB_XCNT(j)]); sum += c; cnt += (c > 0u) ? 1u : 0u; mine = (j == x) ? c : mine; }
        if (sum == G) break;
        __builtin_amdgcn_s_sleep(1);
        if ((++sp & 255u) == 0u) { if (xb_ld(&bar[XB_TMO])) break; if (sp > XB_SPIN_CAP) { atomicAdd(&bar[XB_TMO], 1u); break; } }
    }
    nloc = mine > 0u ? mine : 1u; nx = cnt > 0u ? cnt : 1u;
}
__device__ __forceinline__ void xcd_barrier(const XcdBarrier& b) {
    asm volatile("s_waitcnt vmcnt(0)" ::: "memory");
    __syncthreads();
    if (threadIdx.x == 0) {
        unsigned* bar = b.bar; asm volatile("" : "+s"(bar));
        __builtin_amdgcn_s_waitcnt(0);
        unsigned nloc = b.st[0], nx = b.st[1];
        if (nloc == 0u) { xcd_barrier_complete(bar, b.x, nloc, nx); b.st[0] = nloc; b.st[1] = nx; }
        const unsigned old = xb_add(&bar[XB_XSUB(b.x)], 1u);
        const unsigned gen = old / nloc;
        if (old + 1u == (gen + 1u) * nloc) {
            __builtin_amdgcn_fence(__ATOMIC_RELEASE, "agent");
            asm volatile("s_waitcnt vmcnt(0)" ::: "memory");
            const unsigned og = xb_add(&bar[XB_TOP], 1u);
            const unsigned tg = og / nx;
            if (og + 1u == (tg + 1u) * nx) xb_add(&bar[XB_TOPGEN], 1u);
            else XB_SPIN(xb_ld(&bar[XB_TOPGEN]) == tg, bar);
            __builtin_amdgcn_fence(__ATOMIC_ACQUIRE, "agent");
            xb_add(&bar[XB_XGEN(b.x)], 1u);
            asm volatile("s_waitcnt vmcnt(0)" ::: "memory");
        } else {
            XB_SPIN(xb_ld(&bar[XB_XGEN(b.x)]) == gen, bar);
            __builtin_amdgcn_fence(__ATOMIC_ACQUIRE, "agent");
            asm volatile("s_waitcnt vmcnt(0)" ::: "memory");
        }
    }
    __syncthreads();
}

struct P {
    const float *x, *c, *ada_w, *ada_b, *norm1_g, *norm2_g, *w_in, *conv_w, *sg_norm_g, *sg_w, *sg_b, *rel_bias, *w_branch, *w_o, *peer_wq, *peer_keys, *peer_u, *peer_v, *final_g;
    float* out; unsigned char* ws; int ph_lo, ph_hi;
};
struct Ctx { int tid, lane, wave, G, gtid, NT, gw, NGW; LAS unsigned char* lds; };
typedef const __attribute__((address_space(4))) P* KP;
__device__ __forceinline__ KP kargs() { KP q = (KP)__builtin_amdgcn_kernarg_segment_ptr(); asm volatile("" : "+s"(q)); return q; }
__device__ __forceinline__ Ctx make_ctx() {
    extern __shared__ __attribute__((aligned(16))) unsigned char lds_raw[];
    Ctx c; c.lds = (LAS unsigned char*)lds_raw;
    int tid = threadIdx.x; asm volatile("" : "+v"(tid));
    c.tid = tid; c.lane = tid & 63; c.wave = __builtin_amdgcn_readfirstlane(tid >> 6);
    c.G = gridDim.x; c.gtid = blockIdx.x * NTHR + tid; c.NT = c.G * NTHR; c.gw = blockIdx.x * NWAVES + c.wave; c.NGW = c.G * NWAVES;
    return c;
}

__device__ __forceinline__ void transpose_item(const float* W, int ldw, int K, int mode, bf16* WT, LAS float* scr, int item, int nblk, int lane) {
    const int kb = item / nblk, nb = item % nblk, k0 = 64 * kb, n0 = 32 * nb;
    int sc = n0 + (lane & 31); if (mode == 1) sc = win_src_col(sc); else if (mode == 2) sc = win_src_col(BF_LO + sc);
    float v[32]; const int scc = sc >= 0 ? sc : 0;
#pragma unroll
    for (int i = 0; i < 32; ++i) { const int kk = 2 * i + (lane >> 5); v[i] = W[(size_t)(k0 + kk) * ldw + scc]; }
    asm volatile("" ::: "memory");
#pragma unroll
    for (int i = 0; i < 32; ++i) { const int kk = 2 * i + (lane >> 5); scr[kk * 33 + (lane & 31)] = sc >= 0 ? v[i] : 0.f; }
    LDS_WAIT(); asm volatile("" ::: "memory");
    const int c = lane & 7;
#pragma unroll
    for (int j = 0; j < 4; ++j) { const int n = (lane >> 3) + 8 * j; const LAS float* s = scr + (8 * c) * 33 + n;
        u32x4 o; o.x = pk2(s[0 * 33], s[1 * 33]); o.y = pk2(s[2 * 33], s[3 * 33]); o.z = pk2(s[4 * 33], s[5 * 33]); o.w = pk2(s[6 * 33], s[7 * 33]);
        *(u32x4*)(WT + (size_t)(n0 + n) * K + k0 + 8 * c) = o; }
    LDS_WAIT(); asm volatile("" ::: "memory");
}
__device__ __forceinline__ void cvt_rows(const float* src, bf16* dst, size_t n8, int gtid, int NT) {
    for (size_t i = gtid; i < n8; i += NT) { const f32x4 a = ((const f32x4*)src)[2 * i], b = ((const f32x4*)src)[2 * i + 1];
        u32x4 o; o.x = pk2(a[0], a[1]); o.y = pk2(a[2], a[3]); o.z = pk2(b[0], b[1]); o.w = pk2(b[2], b[3]); ((u32x4*)dst)[i] = o; }
}
__device__ __forceinline__ void phase_prep(KP p, int l) { const Ctx c = make_ctx();
    unsigned char* ws = p->ws;
    LAS float* scr = (LAS float*)(c.lds + c.wave * 16384);
    constexpr int I_IN = (D / 64) * (NPROJ_BF / 32), I_B = (BRW / 64) * (D / 32), I_O = (D / 64) * (D / 32);
    constexpr int NITEMS = I_IN + 4 * I_B + 2 * I_O;
    for (int it = c.gw; it < NITEMS; it += c.NGW) {
        int r = it;
        if (r < I_IN) { transpose_item(p->w_in + (size_t)l * D * PIN, PIN, D, 2, (bf16*)(ws + WS_WIN), scr, r, NPROJ_BF / 32, c.lane); continue; } r -= I_IN;
        if (r < 4 * I_B) { const int i = r / I_B; transpose_item(p->w_branch + ((size_t)l * 4 + i) * BRW * D, D, BRW, 0, (bf16*)(ws + WS_WB) + (size_t)i * D * BRW, scr, r % I_B, D / 32, c.lane); continue; } r -= 4 * I_B;
        if (r < I_O) { transpose_item(p->w_o + (size_t)l * D * D, D, D, 0, (bf16*)(ws + WS_WO), scr, r, D / 32, c.lane); continue; } r -= I_O;
        transpose_item(p->peer_wq + (size_t)l * D * D, D, D, 0, (bf16*)(ws + WS_WQ), scr, r, D / 32, c.lane);
    }
    {
        float* scl = (float*)(ws + WS_SCL);
        const int step = 2 * c.NGW;
#define PT_LOAD(V, R0) do { _Pragma("unroll") for (int h = 0; h < 2; ++h) { const int row = (R0) + h, r = row & 16383; \
            const f32x4* src = (const f32x4*)(((row < 16384) ? p->peer_u : p->peer_v) + ((size_t)l * 16384 + r) * D) + c.lane; \
            _Pragma("unroll") for (int q = 0; q < 8; ++q) V[h][q] = src[64 * q]; } } while (0)
#define PT_DO(V, R0) do { float am[2]; \
            _Pragma("unroll") for (int h = 0; h < 2; ++h) { float a = 0.f; \
                _Pragma("unroll") for (int q = 0; q < 8; ++q) a = fmaxf(a, fmaxf(fmaxf(fabsf(V[h][q][0]), fabsf(V[h][q][1])), fmaxf(fabsf(V[h][q][2]), fabsf(V[h][q][3])))); \
                am[h] = wave_amax(a); } \
            _Pragma("unroll") for (int h = 0; h < 2; ++h) { const int row = (R0) + h, r = row & 16383; const float sc = am[h] > 0.f ? 240.0f / am[h] : 1.0f; \
                const bool isv = row >= 16384;     \
                _Pragma("unroll") for (int q = 0; q < 8; ++q) { int w = 0; w = __builtin_amdgcn_cvt_pk_fp8_f32(V[h][q][0] * sc, V[h][q][1] * sc, w, false); w = __builtin_amdgcn_cvt_pk_fp8_f32(V[h][q][2] * sc, V[h][q][3] * sc, w, true); \
                    const int wi = c.lane + 64 * q;     \
                    unsigned* dst = (unsigned*)(ws + (isv ? WS_V : WS_U) + ((size_t)(wi >> 5) * 16384 + r) * 128) + (wi & 31);     \
                    *dst = (unsigned)w; } \
                if (c.lane == 0) scl[row] = am[h] > 0.f ? am[h] * (1.0f / 240.0f) : 1.0f; } } while (0)
        int row0 = 2 * c.gw;
        if (row0 < 32768) {
            f32x4 va[2][8], vb[2][8];
            PT_LOAD(va, row0);
            for (; row0 + 2 * step < 32768; row0 += 2 * step) {
                PT_LOAD(vb, row0 + step); PT_DO(va, row0);
                PT_LOAD(va, row0 + 2 * step); PT_DO(vb, row0 + step);
            }
            if (row0 + step < 32768) { PT_LOAD(vb, row0 + step); PT_DO(va, row0); PT_DO(vb, row0 + step); }
            else PT_DO(va, row0);
        }
#undef PT_LOAD
#undef PT_DO
    }
    cvt_rows(p->peer_keys + (size_t)l * 262144, (bf16*)(ws + WS_KEYS), (size_t)262144 / 8, c.gtid, c.NT);
    if (l == 0) {
        float* rope = (float*)(ws + WS_ROPE);
        for (int e = c.gtid; e < SEQ * 64; e += c.NT) { const int pos = e >> 6, i = e & 63;
            const float inv = exp2f(-(float)i * (13.287712379549449f / 64.0f));
            const float ang = (float)pos * inv;
            const double rev = (double)ang * 0.15915494309189535; const float fr = (float)(rev - rint(rev));
            rope[2 * e] = __builtin_amdgcn_cosf(fr); rope[2 * e + 1] = __builtin_amdgcn_sinf(fr); }
        __syncthreads();
        LAS float* cact = (LAS float*)c.lds; LAS float* red = (LAS float*)(c.lds + 65536);
        float* mod = (float*)(ws + WS_MOD);
        bool loaded = false;
        for (int u = blockIdx.x; u < 256; u += c.G) {
            if (!loaded) { for (int i = c.tid; i < NBATCH * D; i += NTHR) { const float v = p->c[i]; cact[i] = v / (1.0f + __expf(-v)); } loaded = true; }
            __syncthreads();
            const int layer = u >> 7, col0 = (u & 127) * 96, kk = c.tid >> 5, jj = c.tid & 31;
            float acc[NBATCH][3];
#pragma unroll
            for (int b = 0; b < NBATCH; ++b) { acc[b][0] = 0.f; acc[b][1] = 0.f; acc[b][2] = 0.f; }
            const float* wbase = p->ada_w + (size_t)layer * D * 12288 + col0 + jj;
            for (int i0 = 0; i0 < 128; i0 += 8) {
                float w[8][3];
#pragma unroll
                for (int u = 0; u < 8; ++u) { const float* wr = wbase + (size_t)(kk + 16 * (i0 + u)) * 12288; w[u][0] = wr[0]; w[u][1] = wr[32]; w[u][2] = wr[64]; }
#pragma unroll
                for (int u = 0; u < 8; ++u) { const int k = kk + 16 * (i0 + u);
#pragma unroll
                    for (int b = 0; b < NBATCH; ++b) { const float cb = cact[b * D + k]; acc[b][0] += cb * w[u][0]; acc[b][1] += cb * w[u][1]; acc[b][2] += cb * w[u][2]; } } }
#pragma unroll
            for (int b = 0; b < NBATCH; ++b) { red[kk * 768 + b * 96 + jj] = acc[b][0]; red[kk * 768 + b * 96 + 32 + jj] = acc[b][1]; red[kk * 768 + b * 96 + 64 + jj] = acc[b][2]; }
            __syncthreads();
            for (int o = c.tid; o < 768; o += NTHR) { float s = 0.f;
#pragma unroll
                for (int q = 0; q < 16; ++q) s += red[q * 768 + o];
                const int b = o / 96, cc = o % 96; mod[((size_t)layer * NBATCH + b) * 12288 + col0 + cc] = s + p->ada_b[(size_t)layer * 12288 + col0 + cc]; }
            __syncthreads();
        }
    }
}


__device__ __forceinline__ void gate_col_amax(KP p) {
    const Ctx c = make_ctx();
    int* cs = (int*)(p->ws + WS_CS); LAS float* red = (LAS float*)c.lds;
    constexpr int NCB = (PIN + 255) / 256;
    for (int u = blockIdx.x; u < 2 * NCB * 4; u += c.G) { const int layer = u / (NCB * 4), cb = (u / 4) % NCB, kq = u & 3; const int c4 = cb * 256 + 4 * c.lane; const bool ok = c4 < PIN;
        const float* w = p->w_in + (size_t)layer * D * PIN + (ok ? c4 : 0) + (size_t)(kq * 512 + c.wave * 64) * PIN;
        f32x4 am = (f32x4){0.f, 0.f, 0.f, 0.f};
#pragma unroll 16
        for (int i = 0; i < 64; ++i) { const f32x4 v = *(const f32x4*)(w + (size_t)i * PIN); am = (f32x4){fmaxf(am[0], fabsf(v[0])), fmaxf(am[1], fabsf(v[1])), fmaxf(am[2], fabsf(v[2])), fmaxf(am[3], fabsf(v[3]))}; }
        __syncthreads(); *(LAS f32x4*)(red + c.wave * 256 + 4 * c.lane) = am; __syncthreads();
        if (c.tid < 256 && cb * 256 + c.tid < PIN) { float a = red[c.tid];
#pragma unroll
            for (int q = 1; q < 8; ++q) a = fmaxf(a, red[c.tid + 256 * q]);
            atomicMax(cs + layer * PIN + cb * 256 + c.tid, __float_as_int(a)); }
    }
    __syncthreads();
}
__device__ __forceinline__ void gate_transpose_f8(KP p, int l) {
    const Ctx c = make_ctx();
    LAS float* scr = (LAS float*)(c.lds + c.wave * 16384); const float* cs = (const float*)(p->ws + WS_CS) + l * PIN; float* csd = (float*)(p->ws + WS_CSD); unsigned char* WT = p->ws + WS_WG8;
    const float* W = p->w_in + (size_t)l * D * PIN;
    constexpr int NBLK = N8 / 32, NITEM = (D / 64) * NBLK;
    for (int it = c.gw; it < NITEM; it += c.NGW) { const int kb = it / NBLK, nb = it % NBLK, k0 = 64 * kb, n0 = 32 * nb; const int sc0 = f8_src_col(n0 + (c.lane & 31));
        float v[32];
#pragma unroll
        for (int i = 0; i < 32; ++i) { const int kk = 2 * i + (c.lane >> 5); v[i] = W[(size_t)(k0 + kk) * PIN + sc0]; }
        asm volatile("" ::: "memory");
#pragma unroll
        for (int i = 0; i < 32; ++i) { const int kk = 2 * i + (c.lane >> 5); scr[kk * 33 + (c.lane & 31)] = v[i]; }
        LDS_WAIT(); asm volatile("" ::: "memory");
        const int ch = c.lane & 3;
#pragma unroll
        for (int j = 0; j < 2; ++j) { const int n = (c.lane >> 2) + 16 * j; const float cam = cs[f8_src_col(n0 + n)]; const float sc = cam > 0.f ? 240.0f / cam : 1.0f; const LAS float* sp = scr + (16 * ch) * 33 + n;
            if (kb == 0 && ch == 0) csd[n0 + n] = cam > 0.f ? cam * (1.0f / 240.0f) : 1.0f;
            u32x4 o; unsigned wv[4];
#pragma unroll
            for (int q = 0; q < 4; ++q) { int w = 0; w = __builtin_amdgcn_cvt_pk_fp8_f32(sp[(4 * q) * 33] * sc, sp[(4 * q + 1) * 33] * sc, w, false); w = __builtin_amdgcn_cvt_pk_fp8_f32(sp[(4 * q + 2) * 33] * sc, sp[(4 * q + 3) * 33] * sc, w, true); wv[q] = (unsigned)w; }
            o.x = wv[0]; o.y = wv[1]; o.z = wv[2]; o.w = wv[3];
            *(u32x4*)(WT + (size_t)(n0 + n) * D + k0 + 16 * ch) = o; }
        LDS_WAIT(); asm volatile("" ::: "memory");
    }
}

template <bool F8OUT>
__device__ __forceinline__ void phase_norm_mod(const float* xin, const float* g, const float* sh, const float* sc, bf16* out, unsigned char* out8, float* rs) {
    const Ctx c = make_ctx();
    for (int t = c.gw; t < T; t += c.NGW) {
        const f32x4* xr = (const f32x4*)(xin + (size_t)t * D) + c.lane;
        f32x4 v[8]; float ss = 0.f;
#pragma unroll
        for (int j = 0; j < 8; ++j) { v[j] = xr[64 * j]; ss += (v[j][0] * v[j][0] + v[j][1] * v[j][1]) + (v[j][2] * v[j][2] + v[j][3] * v[j][3]); }
        const float rstd = 1.0f / sqrtf(wave_sum(ss) * (1.0f / D) + EPS);
        const int b = t >> 11;
        const f32x4* gp = (const f32x4*)g + c.lane; const f32x4* shp = (const f32x4*)(sh + (size_t)b * 12288) + c.lane; const f32x4* scp = (const f32x4*)(sc + (size_t)b * 12288) + c.lane;
        u32x2* o8 = (u32x2*)(out + (size_t)t * D) + c.lane; float am = 0.f;
        f32x4 ggv[8], s1v[8], s0v[8];
#pragma unroll
        for (int j = 0; j < 8; ++j) { ggv[j] = gp[64 * j]; s1v[j] = scp[64 * j]; s0v[j] = shp[64 * j]; }
#pragma unroll
        for (int j = 0; j < 8; ++j) { const f32x4 gg = ggv[j], s1 = s1v[j], s0 = s0v[j];
            const f32x4 y = v[j] * rstd * gg * (s1 + 1.0f) + s0; v[j] = y;
            u32x2 w; w.x = pk2(y[0], y[1]); w.y = pk2(y[2], y[3]); o8[64 * j] = w;
            if (F8OUT) am = fmaxf(am, fmaxf(fmaxf(fabsf(y[0]), fabsf(y[1])), fmaxf(fabsf(y[2]), fabsf(y[3])))); }
        if (F8OUT) { am = wave_amax(am); const float q = am > 0.f ? 240.0f / am : 1.0f; unsigned* o1 = (unsigned*)(out8 + (size_t)t * D) + c.lane;
#pragma unroll
            for (int j = 0; j < 8; ++j) { int w = 0; w = __builtin_amdgcn_cvt_pk_fp8_f32(v[j][0] * q, v[j][1] * q, w, false); w = __builtin_amdgcn_cvt_pk_fp8_f32(v[j][2] * q, v[j][3] * q, w, true); o1[64 * j] = (unsigned)w; }
            if (c.lane == 0) rs[t] = am > 0.f ? am * (1.0f / 240.0f) : 1.0f; }
    }
}
__device__ __forceinline__ void phase_final_norm(const float* xin, const float* g, float* out) {
    const Ctx c = make_ctx();
    for (int t = c.gw; t < T; t += c.NGW) {
        const f32x4* xr = (const f32x4*)(xin + (size_t)t * D) + c.lane;
        f32x4 v[8]; float ss = 0.f;
#pragma unroll
        for (int j = 0; j < 8; ++j) { v[j] = xr[64 * j]; ss += (v[j][0] * v[j][0] + v[j][1] * v[j][1]) + (v[j][2] * v[j][2] + v[j][3] * v[j][3]); }
        const float rstd = 1.0f / sqrtf(wave_sum(ss) * (1.0f / D) + EPS);
        const f32x4* gp = (const f32x4*)g + c.lane; f32x4* o = (f32x4*)(out + (size_t)t * D) + c.lane;
#pragma unroll
        for (int j = 0; j < 8; ++j) o[64 * j] = v[j] * rstd * gp[64 * j];
    }
}

__device__ __forceinline__ void dot8(const bf16* A, int lda, int t0, const float* W, int ldw, int col, int K, float (&acc)[8]) {
    for (int k = 0; k < K; ++k) { const float w = W[(size_t)k * ldw + col];
#pragma unroll
        for (int r = 0; r < 8; ++r) acc[r] += bf2f(A[(size_t)(t0 + r) * lda + k]) * w; }
}
__device__ __forceinline__ void naive_proj(KP p, int l) { const Ctx c = make_ctx();
    const bf16* HN = (const bf16*)(p->ws + WS_HN); bf16* PROJ = (bf16*)(p->ws + WS_PROJ); const float* W = p->w_in + (size_t)l * D * PIN; const float* rope = (const float*)(p->ws + WS_ROPE);
    for (int idx = c.gtid; idx < (T / 8) * NPROJ; idx += c.NT) {
        const int tb = idx / NPROJ, j = idx - tb * NPROJ, t0 = tb * 8; const int sc = win_src_col(j);
        float acc[8], acc2[8];
#pragma unroll
        for (int r = 0; r < 8; ++r) { acc[r] = 0.f; acc2[r] = 0.f; }
        if (sc >= 0) dot8(HN, D, t0, W, PIN, sc, D, acc);
        const bool rot = (j >= 4096 && j < 5120);
        if (rot) dot8(HN, D, t0, W, PIN, win_src_col(j ^ 1), D, acc2);
#pragma unroll
        for (int r = 0; r < 8; ++r) { const int t = t0 + r; float v = acc[r];
            if (rot) { const int pos = t & (SEQ - 1), i = (j & 127) >> 1; const float cs = rope[((size_t)pos * 64 + i) * 2], sn = rope[((size_t)pos * 64 + i) * 2 + 1];
                v = (j & 1) ? (acc[r] * cs + acc2[r] * sn) : (acc[r] * cs - acc2[r] * sn); }
            else if (j >= OFF_GATE) v = 1.0f / (1.0f + __expf(-v));
            PROJ[(size_t)t * NPROJ + j] = (bf16)f2bf(v); }
    }
}
__device__ __forceinline__ void naive_branch(KP p, int l) { const Ctx c = make_ctx();
    const bf16* PROJ = (const bf16*)(p->ws + WS_PROJ); const bf16* OBR = (const bf16*)(p->ws + WS_OBR); bf16* Y = (bf16*)(p->ws + WS_Y);
    for (int idx = c.gtid; idx < (T / 8) * D; idx += c.NT) { const int tb = idx / D, d = idx - tb * D, t0 = tb * 8;
        float y[8];
#pragma unroll
        for (int r = 0; r < 8; ++r) y[r] = 0.f;
        for (int i = 0; i < 4; ++i) { float acc[8];
#pragma unroll
            for (int r = 0; r < 8; ++r) acc[r] = 0.f;
            dot8(OBR + (size_t)i * T * BRW, BRW, t0, p->w_branch + ((size_t)l * 4 + i) * BRW * D, D, d, BRW, acc);
#pragma unroll
            for (int r = 0; r < 8; ++r) y[r] += bf2f(PROJ[(size_t)(t0 + r) * NPROJ + OFF_GATE + i * D + d]) * acc[r]; }
#pragma unroll
        for (int r = 0; r < 8; ++r) Y[(size_t)(t0 + r) * D + d] = (bf16)f2bf(y[r]); }
}
__device__ __forceinline__ void naive_wo(KP p, int l, const float* xin) { const Ctx c = make_ctx();
    const bf16* Y = (const bf16*)(p->ws + WS_Y); float* X = (float*)(p->ws + WS_X); const float* g1 = (const float*)(p->ws + WS_MOD) + (size_t)l * NBATCH * 12288 + 2 * D;
    for (int idx = c.gtid; idx < (T / 8) * D; idx += c.NT) { const int tb = idx / D, d = idx - tb * D, t0 = tb * 8;
        float acc[8];
#pragma unroll
        for (int r = 0; r < 8; ++r) acc[r] = 0.f;
        dot8(Y, D, t0, p->w_o + (size_t)l * D * D, D, d, D, acc);
#pragma unroll
        for (int r = 0; r < 8; ++r) { const int t = t0 + r; X[(size_t)t * D + d] = xin[(size_t)t * D + d] + g1[(size_t)(t >> 11) * 12288 + d] * acc[r]; } }
}
__device__ __forceinline__ void naive_wq(KP p, int l) { const Ctx c = make_ctx();
    const bf16* HN = (const bf16*)(p->ws + WS_HN); bf16* QP = (bf16*)(p->ws + WS_QP);
    for (int idx = c.gtid; idx < (T / 8) * D; idx += c.NT) { const int tb = idx / D, d = idx - tb * D, t0 = tb * 8;
        float acc[8];
#pragma unroll
        for (int r = 0; r < 8; ++r) acc[r] = 0.f;
        dot8(HN, D, t0, p->peer_wq + (size_t)l * D * D, D, d, D, acc);
#pragma unroll
        for (int r = 0; r < 8; ++r) QP[(size_t)(t0 + r) * D + d] = (bf16)f2bf(acc[r]); }
}

__device__ __forceinline__ void phase_conv(KP p, int l) { const Ctx c = make_ctx();
    const bf16* PROJ = (const bf16*)(p->ws + WS_PROJ); bf16* OA = (bf16*)(p->ws + WS_OBR); const float* cw = p->conv_w + (size_t)l * 3 * BRW;
    for (int idx0 = c.gtid; idx0 < T * 64; idx0 += 2 * c.NT) {
        u32x4 ov[2];
#pragma unroll
        for (int it = 0; it < 2; ++it) { const int idx = idx0 + it * c.NT; const int idc = idx < T * 64 ? idx : idx0; const int t = idc >> 6, c0 = (idc & 63) * 8, s = t & (SEQ - 1);
            float y[8];
#pragma unroll
            for (int q = 0; q < 8; ++q) y[q] = 0.f;
#pragma unroll
            for (int w = 0; w < 3; ++w) { if (s - 2 + w < 0) continue; const bf16* rp = PROJ + (size_t)(t - 2 + w) * NPROJ + OFF_A;
                const u32x4 gc = *(const u32x4*)(rp + 512 + c0), hv = *(const u32x4*)(rp + 1024 + c0);
                const f32x4 w0 = *(const f32x4*)(cw + w * BRW + c0), w1 = *(const f32x4*)(cw + w * BRW + c0 + 4);
                y[0] += w0[0] * bflo(gc.x) * bflo(hv.x); y[1] += w0[1] * bfhi(gc.x) * bfhi(hv.x); y[2] += w0[2] * bflo(gc.y) * bflo(hv.y); y[3] += w0[3] * bfhi(gc.y) * bfhi(hv.y);
                y[4] += w1[0] * bflo(gc.z) * bflo(hv.z); y[5] += w1[1] * bfhi(gc.z) * bfhi(hv.z); y[6] += w1[2] * bflo(gc.w) * bflo(hv.w); y[7] += w1[3] * bfhi(gc.w) * bfhi(hv.w); }
            const u32x4 gb = *(const u32x4*)(PROJ + (size_t)t * NPROJ + OFF_A + c0);
            ov[it].x = pk2(bflo(gb.x) * y[0], bfhi(gb.x) * y[1]); ov[it].y = pk2(bflo(gb.y) * y[2], bfhi(gb.y) * y[3]); ov[it].z = pk2(bflo(gb.z) * y[4], bfhi(gb.z) * y[5]); ov[it].w = pk2(bflo(gb.w) * y[6], bfhi(gb.w) * y[7]); }
#pragma unroll
        for (int it = 0; it < 2; ++it) { const int idx = idx0 + it * c.NT; if (idx < T * 64) *(u32x4*)(OA + (size_t)(idx >> 6) * BRW + (idx & 63) * 8) = ov[it]; }
    }
}
constexpr int SGS = 136;
__device__ __forceinline__ void phase_sg(KP p, int l) {
    const Ctx c = make_ctx();
    const bf16* PROJ = (const bf16*)(p->ws + WS_PROJ); bf16* OB = (bf16*)(p->ws + WS_OBR) + (size_t)1 * T * BRW;
    const float* ng = p->sg_norm_g + (size_t)l * BRW; const float* sw = p->sg_w + (size_t)l * 4 * 128 * 128; const float* sb = p->sg_b + (size_t)l * 4 * 128;
    LAS float* rstd = (LAS float*)c.lds; LAS bf16* vnT = (LAS bf16*)(c.lds + 1024);
    const int fr = c.lane & 15, g = c.lane >> 4;
    for (int u0 = blockIdx.x; u0 < 256; u0 += c.G) { const int u = (c.G == 256) ? ((u0 & 7) * 32 + (u0 >> 3)) : u0;
        const int hp = u & 1, t0 = (u >> 1) * 128;
        __syncthreads();
        for (int r = c.wave; r < 128; r += NWAVES) { const u32x4 vv = *(const u32x4*)(PROJ + (size_t)(t0 + r) * NPROJ + OFF_SG + 512 + c.lane * 8);
            float ss = bflo(vv.x) * bflo(vv.x) + bfhi(vv.x) * bfhi(vv.x) + bflo(vv.y) * bflo(vv.y) + bfhi(vv.y) * bfhi(vv.y) + bflo(vv.z) * bflo(vv.z) + bfhi(vv.z) * bfhi(vv.z) + bflo(vv.w) * bflo(vv.w) + bfhi(vv.w) * bfhi(vv.w);
            ss = wave_sum(ss); if (c.lane == 0) rstd[r] = 1.0f / sqrtf(ss * (1.0f / BRW) + EPS); }
        __syncthreads();
        for (int item = c.tid; item < 4096; item += NTHR) { const int sp = item & 127, cl = (item >> 7) * 8;
            const u32x4 w = *(const u32x4*)(PROJ + (size_t)(t0 + sp) * NPROJ + OFF_SG + 512 + hp * 256 + cl); const float rs = rstd[sp];
            const f32x4 g0 = *(const f32x4*)(ng + hp * 256 + cl), g1 = *(const f32x4*)(ng + hp * 256 + cl + 4);
            LAS bf16* dst = vnT + cl * SGS + sp;
            dst[0 * SGS] = (bf16)f2bf(bflo(w.x) * rs * g0[0]); dst[1 * SGS] = (bf16)f2bf(bfhi(w.x) * rs * g0[1]); dst[2 * SGS] = (bf16)f2bf(bflo(w.y) * rs * g0[2]); dst[3 * SGS] = (bf16)f2bf(bfhi(w.y) * rs * g0[3]);
            dst[4 * SGS] = (bf16)f2bf(bflo(w.z) * rs * g1[0]); dst[5 * SGS] = (bf16)f2bf(bfhi(w.z) * rs * g1[1]); dst[6 * SGS] = (bf16)f2bf(bflo(w.w) * rs * g1[2]); dst[7 * SGS] = (bf16)f2bf(bfhi(w.w) * rs * g1[3]); }
        __syncthreads();
        const int nks = (c.wave >> 1) + 1, tt = 16 * c.wave + fr;
#pragma unroll 1
        for (int hh = 0; hh < 2; ++hh) { const int gh = 2 * hp + hh;
            f32x4 acc[8];
#pragma unroll
            for (int ct = 0; ct < 8; ++ct) acc[ct] = (f32x4){0.f, 0.f, 0.f, 0.f};
            bf16 uv[4][8]; float bbv[4];
#pragma unroll
            for (int j = 0; j < 4; ++j) { const int t = 16 * c.wave + 4 * g + j; bbv[j] = sb[gh * 128 + t];
                const bf16* up = PROJ + (size_t)(t0 + t) * NPROJ + OFF_SG + hp * 256 + hh * 128 + fr;
#pragma unroll
                for (int ct = 0; ct < 8; ++ct) uv[j][ct] = up[16 * ct]; }
            asm volatile("" ::: "memory");
            for (int ks = 0; ks < nks; ++ks) { const int s0 = 32 * ks + 8 * g; const float* wp = sw + ((size_t)(gh * 128 + tt) * 128 + s0);
                const f32x4 wa = *(const f32x4*)wp, wb = *(const f32x4*)(wp + 4);
                u32x4 aw; aw.x = pk2(s0 + 0 <= tt ? wa[0] : 0.f, s0 + 1 <= tt ? wa[1] : 0.f); aw.y = pk2(s0 + 2 <= tt ? wa[2] : 0.f, s0 + 3 <= tt ? wa[3] : 0.f);
                aw.z = pk2(s0 + 4 <= tt ? wb[0] : 0.f, s0 + 5 <= tt ? wb[1] : 0.f); aw.w = pk2(s0 + 6 <= tt ? wb[2] : 0.f, s0 + 7 <= tt ? wb[3] : 0.f);
                const bf16x8 af = __builtin_bit_cast(bf16x8, aw);
#pragma unroll
                for (int ct = 0; ct < 8; ++ct) { const bf16x8 bfr = *(const LAS bf16x8*)(vnT + (hh * 128 + ct * 16 + fr) * SGS + 32 * ks + 8 * g);
                    acc[ct] = __builtin_amdgcn_mfma_f32_16x16x32_bf16(af, bfr, acc[ct], 0, 0, 0); } }
#pragma unroll
            for (int j = 0; j < 4; ++j) { const int t = 16 * c.wave + 4 * g + j; const float bb = bbv[j];
                bf16* op = OB + (size_t)(t0 + t) * BRW + hp * 256 + hh * 128 + fr;
#pragma unroll
                for (int ct = 0; ct < 8; ++ct) op[16 * ct] = (bf16)f2bf(bf2f(uv[j][ct]) * (acc[ct][j] + bb)); }
        }
    }
    __syncthreads();
}
__device__ __forceinline__ void naive_band(KP p, int l) { const Ctx c = make_ctx();
    const bf16* PROJ = (const bf16*)(p->ws + WS_PROJ); bf16* OC = (bf16*)(p->ws + WS_OBR) + (size_t)2 * T * BRW; const float* rb = p->rel_bias + (size_t)l * 4 * 257;
    for (int item = c.gw; item < T * 4; item += c.NGW) { const int t = item >> 2, h = item & 3, b = t >> 11, s = t & (SEQ - 1), n = s >> 6;
        const int ks0 = (n > 8 ? n - 8 : 0) * 64, ks1 = (n + 1) * 64;
        const unsigned qw = *(const unsigned*)(PROJ + (size_t)t * NPROJ + OFF_BAND + h * 128 + 2 * c.lane); const float q0 = bflo(qw), q1 = bfhi(qw);
        float m = -INFINITY, ls = 0.f, o0 = 0.f, o1 = 0.f;
        for (int kp = ks0; kp < ks1; ++kp) { const bf16* kr = PROJ + (size_t)(b * SEQ + kp) * NPROJ + OFF_BAND + h * 128 + 2 * c.lane;
            const unsigned kw = *(const unsigned*)(kr + 512), vw = *(const unsigned*)(kr + 1024);
            int dd = s - kp; dd = dd < -128 ? -128 : (dd > 128 ? 128 : dd);
            const float sc = wave_sum(q0 * bflo(kw) + q1 * bfhi(kw)) * 0.08838834764831845f + rb[h * 257 + dd + 128];
            const float mn = fmaxf(m, sc), corr = __expf(m - mn), pv = __expf(sc - mn);
            ls = ls * corr + pv; o0 = o0 * corr + pv * bflo(vw); o1 = o1 * corr + pv * bfhi(vw); m = mn; }
        const float inv = 1.0f / ls;
        *(unsigned*)(OC + (size_t)t * BRW + h * 128 + 2 * c.lane) = pk2(o0 * inv, o1 * inv); }
}
__device__ __forceinline__ unsigned f2sortable(float f) { const unsigned u = __float_as_uint(f); return (u & 0x80000000u) ? ~u : (u | 0x80000000u); }
__device__ __forceinline__ void naive_d1(KP p, int l) { const Ctx c = make_ctx();
    const bf16* PROJ = (const bf16*)(p->ws + WS_PROJ); unsigned* MASK = (unsigned*)(p->ws + WS_MASK);
    LAS float* qis = (LAS float*)(c.lds + c.wave * 16384); LAS float* scs = qis + 1088;
    for (int t = c.gw; t < T; t += c.NGW) { const int b = t >> 11, s = t & (SEQ - 1), n = s >> 6, nk = (n + 1) * 64, nkj = n + 1;
        for (int i = c.lane; i < 1040; i += 64) qis[i] = bf2f(PROJ[(size_t)t * NPROJ + OFF_QI + (i < 1024 ? i : (OFF_WI - OFF_QI) + (i - 1024))]);
        LDS_WAIT();
        for (int kb = 0; kb < nk; kb += 64) { const bf16* kr = PROJ + (size_t)(b * SEQ + kb + c.lane) * NPROJ + OFF_KI;
            float ki[64];
#pragma unroll
            for (int q = 0; q < 8; ++q) { const u32x4 w = *(const u32x4*)(kr + 8 * q); ki[8 * q] = bflo(w.x); ki[8 * q + 1] = bfhi(w.x); ki[8 * q + 2] = bflo(w.y); ki[8 * q + 3] = bfhi(w.y); ki[8 * q + 4] = bflo(w.z); ki[8 * q + 5] = bfhi(w.z); ki[8 * q + 6] = bflo(w.w); ki[8 * q + 7] = bfhi(w.w); }
            float score = 0.f;
            for (int hi = 0; hi < 16; ++hi) { float dot = 0.f;
#pragma unroll
                for (int d = 0; d < 64; ++d) dot += qis[hi * 64 + d] * ki[d];
                score += fmaxf(dot * 0.125f, 0.f) * (qis[1024 + hi] * 0.25f); }
            scs[kb + c.lane] = score; }
        LDS_WAIT();
        unsigned* mrow = MASK + (size_t)t * 64;
        if (nk <= 256) { mrow[c.lane] = (c.lane < 2 * nkj) ? 0xffffffffu : 0u; }
        else {
            unsigned u[32];
#pragma unroll
            for (int j = 0; j < 32; ++j) u[j] = (j < nkj) ? f2sortable(scs[64 * j + c.lane]) : 0u;
            unsigned thr = 0u;
            for (int bit = 31; bit >= 0; --bit) { const unsigned cand = thr | (1u << bit); int cnt = 0;
#pragma unroll
                for (int j = 0; j < 32; ++j) if (j < nkj) cnt += __popcll(__ballot(u[j] >= cand));
                if (cnt >= 256) thr = cand; }
            int cgt = 0;
#pragma unroll
            for (int j = 0; j < 32; ++j) if (j < nkj) cgt += __popcll(__ballot(u[j] > thr));
            const int need = 256 - cgt; int taken = 0;
            const unsigned long long ltmask = (c.lane == 0) ? 0ull : (~0ull >> (64 - c.lane));
#pragma unroll
            for (int j = 0; j < 32; ++j) { unsigned long long selm = 0ull;
                if (j < nkj) { const bool eq = (u[j] == thr); const unsigned long long eqm = __ballot(eq);
                    const bool sel = (u[j] > thr) || (eq && (taken + __popcll(eqm & ltmask)) < need); taken += __popcll(eqm); selm = __ballot(sel); }
                if (c.lane == 0) { mrow[2 * j] = (unsigned)selm; mrow[2 * j + 1] = (unsigned)(selm >> 32); } }
        }
    }
}
__device__ __forceinline__ void naive_d2(KP p, int l) { const Ctx c = make_ctx();
    const bf16* PROJ = (const bf16*)(p->ws + WS_PROJ); const unsigned* MASK = (const unsigned*)(p->ws + WS_MASK); bf16* OD = (bf16*)(p->ws + WS_OBR) + (size_t)3 * T * BRW;
    LAS float* qs = (LAS float*)(c.lds + c.wave * 16384); LAS float* sb = qs + 128;
    for (int t = c.gw; t < T; t += c.NGW) { const int b = t >> 11, s = t & (SEQ - 1), n = s >> 6, nk = (n + 1) * 64;
        for (int h = 0; h < 4; ++h) {
            { const unsigned qw = *(const unsigned*)(PROJ + (size_t)t * NPROJ + OFF_DSA + h * 128 + 2 * c.lane); qs[2 * c.lane] = bflo(qw); qs[2 * c.lane + 1] = bfhi(qw); }
            LDS_WAIT();
            float mx = -INFINITY;
            for (int kb = 0; kb < nk; kb += 64) { const int key = kb + c.lane; const unsigned mw = MASK[(size_t)t * 64 + (key >> 5)]; const bool sel = (mw >> (key & 31)) & 1u;
                float dot = -INFINITY;
                if (sel) { const bf16* kr = PROJ + (size_t)(b * SEQ + key) * NPROJ + OFF_DSA + 512 + h * 128; dot = 0.f;
#pragma unroll
                    for (int q = 0; q < 16; ++q) { const u32x4 w = *(const u32x4*)(kr + 8 * q);
                        dot += qs[8 * q] * bflo(w.x) + qs[8 * q + 1] * bfhi(w.x) + qs[8 * q + 2] * bflo(w.y) + qs[8 * q + 3] * bfhi(w.y) + qs[8 * q + 4] * bflo(w.z) + qs[8 * q + 5] * bfhi(w.z) + qs[8 * q + 6] * bflo(w.w) + qs[8 * q + 7] * bfhi(w.w); }
                    dot *= 0.08838834764831845f; }
                sb[key] = dot; mx = fmaxf(mx, dot); }
            mx = wave_max(mx);
            float ls = 0.f;
            for (int kb = 0; kb < nk; kb += 64) { const float sv = sb[kb + c.lane]; const float pv = (sv == -INFINITY) ? 0.f : __expf(sv - mx); sb[kb + c.lane] = pv; ls += pv; }
            ls = wave_sum(ls);
            LDS_WAIT();
            float o0 = 0.f, o1 = 0.f;
            for (int key = 0; key < nk; ++key) { const float pv = sb[key];
                if (pv != 0.f) { const unsigned vw = *(const unsigned*)(PROJ + (size_t)(b * SEQ + key) * NPROJ + OFF_DSA + 1024 + h * 128 + 2 * c.lane); o0 += pv * bflo(vw); o1 += pv * bfhi(vw); } }
            const float inv = 1.0f / ls;
            *(unsigned*)(OD + (size_t)t * BRW + h * 128 + 2 * c.lane) = pk2(o0 * inv, o1 * inv);
            LDS_WAIT();
        }
    }
}

typedef short s16x4 __attribute__((ext_vector_type(4)));
__device__ __forceinline__ s16x4 lds_tr16(const LAS bf16* p) { return __builtin_bit_cast(s16x4, __builtin_amdgcn_ds_read_tr16_b64_v4i16((LAS s16x4*)p)); }
constexpr int VST = 144;
constexpr int KST = 136;
constexpr int ATT_KBUF = 32 * KST * 2, ATT_VBUF = 32 * VST * 2;
constexpr int ATT_V_OFF = 4 * ATT_KBUF;
constexpr int ATT_BIAS_OFF = ATT_V_OFF + 4 * ATT_VBUF;
#define WG_BAR_LDS() do { asm volatile("s_waitcnt lgkmcnt(0)" ::: "memory"); __builtin_amdgcn_s_barrier(); asm volatile("" ::: "memory"); } while (0)
template <int MODE>
__device__ __forceinline__ void attn_unit(const Ctx& c, const bf16* PROJ, const int qoff, const unsigned* MASK, bf16* OUT, const int b, const int n, const int hp) {
    const int hl = c.wave >> 2, h = 2 * hp + hl, q4 = c.wave & 3, r0 = q4 * 16, fr = c.lane & 15, g = c.lane >> 4;
    const int tq = b * SEQ + n * 64 + r0 + fr;
    const int koff = qoff + 512 + h * 128, voff = qoff + 1024 + h * 128;
    bf16x8 qf[4];
#pragma unroll
    for (int ks = 0; ks < 4; ++ks) qf[ks] = *(const bf16x8*)(PROJ + (size_t)tq * NPROJ + qoff + h * 128 + 32 * ks + 8 * g);
    f32x4 O[8];
#pragma unroll
    for (int dt = 0; dt < 8; ++dt) O[dt] = (f32x4){0.f, 0.f, 0.f, 0.f};
    float m = -1e30f, lsum = 0.f;
    const int kbeg = (MODE == 0) ? (n > 8 ? n - 8 : 0) * 64 : 0, kend = (n + 1) * 64, nsteps = (kend - kbeg) >> 5;
    LAS bf16* kls = (LAS bf16*)c.lds + (size_t)(hl * 2) * 32 * KST;
    LAS bf16* vls = (LAS bf16*)(c.lds + ATT_V_OFF) + (size_t)(hl * 2) * 32 * VST;
    const LAS float* bias = (const LAS float*)(c.lds + ATT_BIAS_OFF) + hl * 257;
    const int qpos = n * 64 + r0 + fr;
    const bf16* kvbase = PROJ + (size_t)(b * SEQ) * NPROJ;
    u32x4 rkA[2], rvA[2], rkB[2], rvB[2];
    const int cid0 = q4 * 128 + c.lane;
#define LOADG(RK, RV, kb) do { const int _kb = (kb) < kend - 32 ? (kb) : kend - 32; _Pragma("unroll") for (int _i = 0; _i < 2; ++_i) { const int _cid = cid0 + 64 * _i; const bf16* _r = kvbase + (size_t)(_kb + (_cid >> 4)) * NPROJ + (_cid & 15) * 8; \
        RK[_i] = *(const u32x4*)(_r + koff); RV[_i] = *(const u32x4*)(_r + voff); } } while (0)
#define WRITEL(RK, RV, buf) do { _Pragma("unroll") for (int _i = 0; _i < 2; ++_i) { const int _cid = cid0 + 64 * _i; \
        *(LAS u32x4*)(kls + (buf) * 32 * KST + (_cid >> 4) * KST + (_cid & 15) * 8) = RK[_i]; *(LAS u32x4*)(vls + (buf) * 32 * VST + (_cid >> 4) * VST + (_cid & 15) * 8) = RV[_i]; } } while (0)
    unsigned mwn = 0u; if (MODE == 1) mwn = MASK[(size_t)tq * 64 + (kbeg >> 5)];
    LOADG(rkA, rvA, kbeg); WRITEL(rkA, rvA, 0); LOADG(rkB, rvB, kbeg + 32); LOADG(rkA, rvA, kbeg + 64);
    WG_BAR_LDS();
    auto step = [&](const int kb, const int buf) {
        const LAS bf16* Kb = kls + buf * 32 * KST; const LAS bf16* Vb = vls + buf * 32 * VST;
        f32x4 sa = (f32x4){0.f, 0.f, 0.f, 0.f}, sb = sa;
#pragma unroll
        for (int ks = 0; ks < 4; ++ks) { const bf16x8 ka = *(const LAS bf16x8*)(Kb + fr * KST + 32 * ks + 8 * g), kc = *(const LAS bf16x8*)(Kb + (16 + fr) * KST + 32 * ks + 8 * g);
            sa = __builtin_amdgcn_mfma_f32_16x16x32_bf16(ka, qf[ks], sa, 0, 0, 0); sb = __builtin_amdgcn_mfma_f32_16x16x32_bf16(kc, qf[ks], sb, 0, 0, 0); }
        float sv[8];
        if (MODE == 0) { const int d0 = qpos - (kb + 4 * g);
#pragma unroll
            for (int j = 0; j < 4; ++j) { int da = d0 - j, db = d0 - 16 - j; da = da > 128 ? 128 : da; db = db > 128 ? 128 : db;
                sv[j] = sa[j] * 0.12751743f + bias[da + 128]; sv[4 + j] = sb[j] * 0.12751743f + bias[db + 128]; } }
        else { const unsigned mw = mwn >> (4 * g); { const int wn = (kb >> 5) + 1; mwn = MASK[(size_t)tq * 64 + (wn < (kend >> 5) ? wn : (kend >> 5) - 1)]; }
#pragma unroll
            for (int j = 0; j < 4; ++j) { sv[j] = ((mw >> j) & 1u) ? sa[j] * 0.12751743f : -INFINITY; sv[4 + j] = ((mw >> (16 + j)) & 1u) ? sb[j] * 0.12751743f : -INFINITY; } }
        float mx = fmaxf(fmaxf(fmaxf(sv[0], sv[1]), fmaxf(sv[2], sv[3])), fmaxf(fmaxf(sv[4], sv[5]), fmaxf(sv[6], sv[7])));
        mx = fmaxf(mx, __shfl_xor(mx, 16)); mx = fmaxf(mx, __shfl_xor(mx, 32));
        const float mn = fmaxf(m, mx), corr = __builtin_amdgcn_exp2f(m - mn);
        const bool grew = mn > m; m = mn;
        float ps = 0.f;
#pragma unroll
        for (int j = 0; j < 8; ++j) { sv[j] = __builtin_amdgcn_exp2f(sv[j] - mn); ps += sv[j]; }
        lsum = lsum * corr + ps;
        if (__ballot(grew) != 0ull) {
#pragma unroll
            for (int dt = 0; dt < 8; ++dt) O[dt] = O[dt] * corr; }
        u32x4 pw; pw.x = pg8::cvt_pk_bf16(sv[0], sv[1]); pw.y = pg8::cvt_pk_bf16(sv[2], sv[3]); pw.z = pg8::cvt_pk_bf16(sv[4], sv[5]); pw.w = pg8::cvt_pk_bf16(sv[6], sv[7]);
        const bf16x8 pf = __builtin_bit_cast(bf16x8, pw);
        const LAS bf16* vr = Vb + (4 * g + (fr >> 2)) * VST + 4 * (fr & 3);
#pragma unroll
        for (int dt = 0; dt < 8; ++dt) { const s16x4 va = lds_tr16(vr + 16 * dt), vb = lds_tr16(vr + 16 * VST + 16 * dt);
            const bf16x8 vf = (bf16x8){va[0], va[1], va[2], va[3], vb[0], vb[1], vb[2], vb[3]};
            O[dt] = __builtin_amdgcn_mfma_f32_16x16x32_bf16(vf, pf, O[dt], 0, 0, 0); }
    };
    for (int st = 0; st < nsteps; st += 2) { const int kb = kbeg + 32 * st;
        step(kb, 0);      WRITEL(rkB, rvB, 1); LOADG(rkB, rvB, kb + 96);  WG_BAR_LDS();
        step(kb + 32, 1); WRITEL(rkA, rvA, 0); LOADG(rkA, rvA, kb + 128); WG_BAR_LDS();
    }
#undef LOADG
#undef WRITEL
    lsum += __shfl_xor(lsum, 16); lsum += __shfl_xor(lsum, 32);
    const float inv = 1.0f / lsum;
    bf16* op = OUT + (size_t)tq * BRW + h * 128 + 4 * g;
#pragma unroll
    for (int dt = 0; dt < 8; ++dt) { u32x2 w; w.x = pg8::cvt_pk_bf16(O[dt][0] * inv, O[dt][1] * inv); w.y = pg8::cvt_pk_bf16(O[dt][2] * inv, O[dt][3] * inv); *(u32x2*)(op + 16 * dt) = w; }
}
__device__ __forceinline__ void phase_band(KP p, int l) {
    const Ctx c = make_ctx();
    const bf16* PROJ = (const bf16*)(p->ws + WS_PROJ); bf16* OC = (bf16*)(p->ws + WS_OBR) + (size_t)2 * T * BRW; const float* rb = p->rel_bias + (size_t)l * 4 * 257;
    LAS float* bias = (LAS float*)(c.lds + ATT_BIAS_OFF);
    for (int u0 = blockIdx.x; u0 < 512; u0 += c.G) { const int u = (c.G == 256) ? ((u0 & 7) * 64 + (u0 >> 8) * 32 + ((u0 >> 3) & 31)) : u0;
        const int hp = u & 1, n = (u >> 1) & 31, b = u >> 6;
        __syncthreads();
        for (int i = c.tid; i < 2 * 257; i += NTHR) bias[i] = rb[(2 * hp) * 257 + i] * 1.4426950408889634f;
        __syncthreads();
        attn_unit<0>(c, PROJ, OFF_BAND, nullptr, OC, b, n, hp);
    }
    __syncthreads();
}
__device__ __forceinline__ void phase_d2(KP p, int l) {
    const Ctx c = make_ctx();
    const bf16* PROJ = (const bf16*)(p->ws + WS_PROJ); bf16* OD = (bf16*)(p->ws + WS_OBR) + (size_t)3 * T * BRW; const unsigned* MASK = (const unsigned*)(p->ws + WS_MASK);
    for (int i = blockIdx.x; i < 512; i += c.G) {
        int n, b, hp;
        if (c.G == 256) { const int idx = (i >> 3) & 31, r = i >> 8; b = i & 7; hp = idx & 1; const int m = idx >> 1; n = r ? m : 31 - m; }
        else { const int rank = (i < 256) ? i : 767 - i; n = 31 - (rank >> 4); b = (rank & 15) >> 1; hp = rank & 1; }
        attn_unit<1>(c, PROJ, OFF_DSA, MASK, OD, b, n, hp);
    }
}
template <int NJ>
__device__ __forceinline__ void select_row_t(const LAS float* row, const int nkj, unsigned* mrow, const int lane, LAS unsigned* hb) {
    unsigned u[NJ];
#pragma unroll
    for (int j = 0; j < NJ; ++j) { const unsigned v = f2sortable(row[64 * j + lane]); u[j] = (j < nkj) ? v : 0u; }
    unsigned thr = 0u; int rk = 256;
#pragma unroll 1
    for (int pass = 0; pass < 4; ++pass) { const int shift = 24 - 8 * pass;
#pragma unroll
        for (int i = 0; i < 4; ++i) hb[lane + 64 * i] = 0u;
        const unsigned hmask = pass == 0 ? 0u : (0xffffffffu << (shift + 8));
#pragma unroll
        for (int j = 0; j < NJ; ++j) { const unsigned v = u[j]; if (v != 0u && ((v ^ thr) & hmask) == 0u) (void)__hip_atomic_fetch_add((unsigned*)(hb + ((v >> shift) & 255u)), 1u, __ATOMIC_RELAXED, __HIP_MEMORY_SCOPE_WORKGROUP); }
        asm volatile("s_waitcnt lgkmcnt(0)" ::: "memory");
        const unsigned c0 = hb[255 - 4 * lane], c1 = hb[254 - 4 * lane], c2 = hb[253 - 4 * lane], c3 = hb[252 - 4 * lane];
        const int ls = (int)(c0 + c1 + c2 + c3); int incl = ls;
#define SCAN_ADD(ctl, rmask, bc) incl += __builtin_amdgcn_update_dpp(0, incl, (ctl), (rmask), 0xf, (bc))
        SCAN_ADD(0x111, 0xf, true); SCAN_ADD(0x112, 0xf, true); SCAN_ADD(0x114, 0xf, true); SCAN_ADD(0x118, 0xf, true); SCAN_ADD(0x142, 0xa, false); SCAN_ADD(0x143, 0xc, false);
#undef SCAN_ADD
        const int excl = incl - ls;
        const unsigned long long hit = __ballot(excl < rk && rk <= incl);
        const int L = hit ? (int)__builtin_ctzll(hit) : 63;
        int run = __builtin_amdgcn_readlane(excl, L); const int b0 = __builtin_amdgcn_readlane((int)c0, L), b1 = __builtin_amdgcn_readlane((int)c1, L), b2 = __builtin_amdgcn_readlane((int)c2, L);
        int dsel = 255 - 4 * L;
        if (run + b0 < rk) { run += b0; --dsel; if (run + b1 < rk) { run += b1; --dsel; if (run + b2 < rk) { run += b2; --dsel; } } }
        rk -= run; thr |= (unsigned)dsel << shift; }
    int cgt = 0;
#pragma unroll
    for (int j = 0; j < NJ; ++j) cgt += __popcll(__ballot(u[j] > thr));
    const int need = 256 - cgt; int taken = 0;
    const unsigned long long ltmask = (lane == 0) ? 0ull : (~0ull >> (64 - lane));
#pragma unroll
    for (int j = 0; j < NJ; ++j) { const bool eq = (u[j] == thr); const unsigned long long eqm = __ballot(eq);
        const bool sel = (u[j] > thr) || (eq && (taken + __popcll(eqm & ltmask)) < need); taken += __popcll(eqm); const unsigned long long selm = __ballot(sel);
        if (lane == 0 && j < nkj) { mrow[2 * j] = (unsigned)selm; mrow[2 * j + 1] = (unsigned)(selm >> 32); } }
}
__device__ __forceinline__ void select_row(const LAS float* row, const int nkj, unsigned* mrow, const int lane, LAS unsigned* hb) {
    if (nkj <= 4) { if (lane < 2 * nkj) mrow[lane] = 0xffffffffu; return; }
    if (nkj <= 8) select_row_t<8>(row, nkj, mrow, lane, hb);
    else if (nkj <= 16) select_row_t<16>(row, nkj, mrow, lane, hb);
    else if (nkj <= 24) select_row_t<24>(row, nkj, mrow, lane, hb);
    else select_row_t<32>(row, nkj, mrow, lane, hb);
}
constexpr int SCS = 2052;
constexpr int D1_WIT_OFF = 16 * SCS * 4;
__device__ __forceinline__ void phase_d1(KP p, int l) {
    const Ctx c = make_ctx();
    const bf16* PROJ = (const bf16*)(p->ws + WS_PROJ); unsigned* MASK = (unsigned*)(p->ws + WS_MASK);
    LAS float* SC = (LAS float*)c.lds; LAS float* WIT = (LAS float*)(c.lds + D1_WIT_OFF);
    const int fr = c.lane & 15, g = c.lane >> 4;
    for (int i = blockIdx.x; i < 1024; i += c.G) {
        int n, b, qtr;
        if (c.G == 256) { const int idx = (i >> 3) & 31, r = i >> 8, m = idx >> 2; b = i & 7; qtr = idx & 3; n = (r == 0) ? 31 - m : (r == 1) ? 16 + m : (r == 2) ? 15 - m : m; }
        else { const int r = i >> 8, s = i & 255, rank = r * 256 + ((r & 1) ? 255 - s : s); n = 31 - (rank >> 5); b = (rank & 31) >> 2; qtr = rank & 3; }
        const int nk = (n + 1) * 64, t0 = b * SEQ + n * 64 + qtr * 16;
        __syncthreads();
        if (c.tid < 256) { const int q = c.tid & 15, hi = c.tid >> 4; WIT[hi * 16 + q] = bf2f(PROJ[(size_t)(t0 + q) * NPROJ + OFF_WI + hi]) * 0.25f; }
        bf16x8 af[16][2];
#pragma unroll
        for (int hi = 0; hi < 16; ++hi)
#pragma unroll
            for (int ks = 0; ks < 2; ++ks) af[hi][ks] = *(const bf16x8*)(PROJ + (size_t)(t0 + fr) * NPROJ + OFF_QI + hi * 64 + 32 * ks + 8 * g);
        __syncthreads();
        const int nkt = nk / 16;
#define D1_LOADK(dst, kt_) do { const int _kt = (kt_) < nkt ? (kt_) : nkt - 1; _Pragma("unroll") for (int ks = 0; ks < 2; ++ks) dst[ks] = *(const bf16x8*)(PROJ + (size_t)(b * SEQ + _kt * 16 + fr) * NPROJ + OFF_KI + 32 * ks + 8 * g); } while (0)
        bf16x8 bq0[2], bq1[2];
        D1_LOADK(bq0, c.wave); D1_LOADK(bq1, c.wave + NWAVES);
        for (int kt = c.wave; kt < nkt; kt += NWAVES) {
            bf16x8 bfr[2]; bfr[0] = bq0[0]; bfr[1] = bq0[1]; bq0[0] = bq1[0]; bq0[1] = bq1[1];
            D1_LOADK(bq1, kt + 2 * NWAVES);
            f32x4 score = (f32x4){0.f, 0.f, 0.f, 0.f};
#pragma unroll
            for (int hq = 0; hq < 16; hq += 4) {
                f32x4 acc[4];
#pragma unroll
                for (int d = 0; d < 4; ++d) acc[d] = __builtin_amdgcn_mfma_f32_16x16x32_bf16(af[hq + d][0], bfr[0], (f32x4){0.f, 0.f, 0.f, 0.f}, 0, 0, 0);
#pragma unroll
                for (int d = 0; d < 4; ++d) acc[d] = __builtin_amdgcn_mfma_f32_16x16x32_bf16(af[hq + d][1], bfr[1], acc[d], 0, 0, 0);
#pragma unroll
                for (int d = 0; d < 4; ++d) { const f32x4 w4 = *(const LAS f32x4*)(WIT + (hq + d) * 16 + 4 * g);
#pragma unroll
                    for (int j = 0; j < 4; ++j) score[j] += fmaxf(acc[d][j] * 0.125f, 0.f) * w4[j]; } }
#pragma unroll
            for (int j = 0; j < 4; ++j) SC[(4 * g + j) * SCS + kt * 16 + fr] = score[j];
        }
#undef D1_LOADK
        __syncthreads();
#pragma unroll 1
        for (int q2 = 0; q2 < 2; ++q2) { const int qq = c.wave * 2 + q2; select_row(SC + qq * SCS, n + 1, MASK + (size_t)(t0 + qq) * 64, c.lane, (LAS unsigned*)(c.lds + D1_WIT_OFF + 1024) + c.wave * 256); }
    }
    __syncthreads();
}

__device__ __forceinline__ void naive_psel(KP p, int l) { const Ctx c = make_ctx();
    const bf16* QP = (const bf16*)(p->ws + WS_QP); float* SC = (float*)(p->ws + WS_SC); int* SCI = (int*)(p->ws + WS_SCI);
    int* EIDX = (int*)(p->ws + WS_EIDX); float* GWT = (float*)(p->ws + WS_GW); const float* keys = p->peer_keys + (size_t)l * 262144;
    for (int item = c.gtid; item < T * 8; item += c.NT) { const int t = item >> 3, h = item & 7;
        float* sc = SC + (size_t)item * 256; int* sci = SCI + (size_t)item * 256;
        const bf16* qrow = QP + (size_t)t * D + h * 256;
        for (int pk = 0; pk < 256; ++pk) { const int ph = pk >> 7; const float* kr = keys + ((size_t)(h * 2 + ph) * 128 + (pk & 127)) * 128; float dot = 0.f;
            for (int d = 0; d < 128; ++d) dot += bf2f(qrow[ph * 128 + d]) * kr[d];
            sc[pk] = dot; }
        float sv0[16], sv1[16]; int si0[16], si1[16];
#pragma unroll
        for (int r = 0; r < 16; ++r) { float best = -INFINITY; int bi = 0;
            for (int k = 0; k < 128; ++k) { const float v = sc[k]; if (v > best) { best = v; bi = k; } }
            sv0[r] = best; si0[r] = bi; sc[bi] = -INFINITY; }
#pragma unroll
        for (int r = 0; r < 16; ++r) { float best = -INFINITY; int bi = 0;
            for (int k = 0; k < 128; ++k) { const float v = sc[128 + k]; if (v > best) { best = v; bi = k; } }
            sv1[r] = best; si1[r] = bi; sc[128 + bi] = -INFINITY; }
#pragma unroll
        for (int i = 0; i < 16; ++i)
#pragma unroll
            for (int j = 0; j < 16; ++j) { sc[i * 16 + j] = sv0[i] + sv1[j]; sci[i * 16 + j] = si0[i] * 128 + si1[j]; }
        float fv[16]; int fe[16];
#pragma unroll
        for (int r = 0; r < 16; ++r) { float best = -INFINITY; int bi = 0;
            for (int k = 0; k < 256; ++k) { const float v = sc[k]; if (v > best) { best = v; bi = k; } }
            fv[r] = best; fe[r] = sci[bi]; sc[bi] = -INFINITY; }
        float es[16], sum = 0.f;
#pragma unroll
        for (int r = 0; r < 16; ++r) { es[r] = __expf(fv[r] - fv[0]); sum += es[r]; }
        const float inv = 1.0f / sum;
#pragma unroll
        for (int r = 0; r < 16; ++r) { EIDX[(size_t)t * 128 + h * 16 + r] = fe[r]; GWT[(size_t)t * 128 + h * 16 + r] = es[r] * inv; }
    }
}

typedef __bf16 bf16x2_t __attribute__((ext_vector_type(2)));
__device__ __forceinline__ float dot2bf(unsigned a, unsigned b, float acc) { return __builtin_amdgcn_fdot2_f32_bf16(__builtin_bit_cast(bf16x2_t, a), __builtin_bit_cast(bf16x2_t, b), acc, false); }
__device__ __forceinline__ float from_sortable(unsigned u) { return __uint_as_float((u & 0x80000000u) ? (u & 0x7fffffffu) : ~u); }
__device__ __forceinline__ float gelu_tanh(float x) { const float u = 0.7978845608028654f * (x + 0.044715f * x * x * x); const float e = __expf(2.0f * u); return 0.5f * x * (1.0f + (1.0f - 2.0f / (e + 1.0f))); }
__device__ __forceinline__ void naive_pgather(KP p, int l) { const Ctx c = make_ctx();
    const bf16* HN = (const bf16*)(p->ws + WS_HN); float* X = (float*)(p->ws + WS_X); const int* EIDX = (const int*)(p->ws + WS_EIDX); const float* GWT = (const float*)(p->ws + WS_GW);
    const float* U = p->peer_u + (size_t)l * 16384 * D; const float* V = p->peer_v + (size_t)l * 16384 * D; const float* g2 = (const float*)(p->ws + WS_MOD) + (size_t)l * NBATCH * 12288 + 5 * D;
    for (int t = c.gw; t < T; t += c.NGW) {
        f32x4 hv[8], y[8];
#pragma unroll
        for (int j = 0; j < 8; ++j) { const u32x2 w = *((const u32x2*)(HN + (size_t)t * D) + c.lane + 64 * j); hv[j] = (f32x4){bflo(w.x), bfhi(w.x), bflo(w.y), bfhi(w.y)}; y[j] = (f32x4){0.f, 0.f, 0.f, 0.f}; }
        for (int e = 0; e < 128; ++e) { const int idx = EIDX[(size_t)t * 128 + e]; const float gwt = GWT[(size_t)t * 128 + e];
            const f32x4* ur = (const f32x4*)(U + (size_t)idx * D) + c.lane; float part = 0.f;
#pragma unroll
            for (int j = 0; j < 8; ++j) { const f32x4 uu = ur[64 * j]; part += (hv[j][0] * uu[0] + hv[j][1] * uu[1]) + (hv[j][2] * uu[2] + hv[j][3] * uu[3]); }
            const float a = wave_sum(part); const float hh = gelu_tanh(a) * gwt;
            const f32x4* vr = (const f32x4*)(V + (size_t)idx * D) + c.lane;
#pragma unroll
            for (int j = 0; j < 8; ++j) y[j] += vr[64 * j] * hh; }
        f32x4* xr = (f32x4*)(X + (size_t)t * D) + c.lane; const f32x4* gp = (const f32x4*)(g2 + (size_t)(t >> 11) * 12288) + c.lane;
#pragma unroll
        for (int j = 0; j < 8; ++j) xr[64 * j] = xr[64 * j] + gp[64 * j] * y[j];
    }
}

#define INS16(L, v) do { unsigned _v = (v); _Pragma("unroll") for (int _i = 0; _i < 16; ++_i) { const unsigned _t = max(L[_i], _v); _v = min(L[_i], _v); L[_i] = _t; } } while (0)
__device__ __forceinline__ void phase_psel(KP p, int l) {
    const Ctx c = make_ctx();
    const bf16* QP = (const bf16*)(p->ws + WS_QP); const bf16* KEYS = (const bf16*)(p->ws + WS_KEYS); int* EIDX = (int*)(p->ws + WS_EIDX); float* GWT = (float*)(p->ws + WS_GW);
    LAS unsigned* SL = (LAS unsigned*)c.lds;
    const int fr = c.lane & 15, fq = c.lane >> 4;
    for (int u = blockIdx.x; u < T / 64; u += c.G) { const int t0 = u * 64;
        for (int hp = 0; hp < 4; ++hp) {
            __syncthreads();
            {
                const int hh = c.wave >> 2, ph = (c.wave >> 1) & 1, th = c.wave & 1, h = 2 * hp + hh;
                bf16x8 af[2][4];
#pragma unroll
                for (int mt = 0; mt < 2; ++mt)
#pragma unroll
                    for (int ks = 0; ks < 4; ++ks) af[mt][ks] = *(const bf16x8*)(QP + (size_t)(t0 + th * 32 + mt * 16 + fr) * D + h * 256 + ph * 128 + ks * 32 + fq * 8);
                const bf16* kb = KEYS + (size_t)(h * 2 + ph) * 128 * 128;
                bf16x8 bfr[8][4];
#pragma unroll
                for (int nt = 0; nt < 8; ++nt)
#pragma unroll
                    for (int ks = 0; ks < 4; ++ks) bfr[nt][ks] = *(const bf16x8*)(kb + (size_t)(nt * 16 + fr) * 128 + ks * 32 + fq * 8);
#pragma unroll
                for (int nt = 0; nt < 8; ++nt) {
#pragma unroll
                    for (int mt = 0; mt < 2; ++mt) { f32x4 acc = (f32x4){0.f, 0.f, 0.f, 0.f};
#pragma unroll
                        for (int ks = 0; ks < 4; ++ks) acc = __builtin_amdgcn_mfma_f32_16x16x32_bf16(af[mt][ks], bfr[nt][ks], acc, 0, 0, 0);
#pragma unroll
                        for (int j = 0; j < 4; ++j) { const int tok = th * 32 + mt * 16 + fq * 4 + j, key = nt * 16 + fr;
                            SL[((tok * 2 + hh) * 2 + ph) * 129 + key] = (f2sortable(acc[j]) & ~127u) | (unsigned)key; } }
                }
            }
            __syncthreads();
            {
                unsigned L[16];
#pragma unroll
                for (int i = 0; i < 16; ++i) L[i] = 0u;
                LAS unsigned* row = SL + (c.tid >> 1) * 129; const LAS unsigned* hrow = row + (c.tid & 1) * 64;
                for (int k = 0; k < 64; k += 4) { const unsigned v0 = hrow[k], v1 = hrow[k + 1], v2 = hrow[k + 2], v3 = hrow[k + 3]; INS16(L, v0); INS16(L, v1); INS16(L, v2); INS16(L, v3); }
                unsigned M[16];
#pragma unroll
                for (int i = 0; i < 16; ++i) { const unsigned o = (unsigned)__builtin_amdgcn_mov_dpp((int)L[15 - i], 0xB1, 0xf, 0xf, true); M[i] = max(L[i], o); }
#pragma unroll
                for (int st = 8; st >= 1; st >>= 1)
#pragma unroll
                    for (int i = 0; i < 16; ++i) if ((i & st) == 0) { const unsigned a = M[i], b = M[i + st]; M[i] = max(a, b); M[i + st] = min(a, b); }
                __syncthreads();
                if ((c.tid & 1) == 0) {
#pragma unroll
                    for (int i = 0; i < 16; ++i) row[i] = M[i]; }
            }
            __syncthreads();
            if (c.tid < 256 && (c.tid & 1) == 0) {
                LAS unsigned* r0 = SL + c.tid * 129; LAS unsigned* r1 = r0 + 129;
                float s0[16], s1[16];
#pragma unroll
                for (int i = 0; i < 16; ++i) { s0[i] = from_sortable(r0[i] & ~127u); s1[i] = from_sortable(r1[i] & ~127u); }
                unsigned L[16];
#pragma unroll
                for (int i = 0; i < 16; ++i) L[i] = 0u;
#pragma unroll
                for (int i = 0; i < 16; ++i)
#pragma unroll
                    for (int j = 0; j < 16; ++j) if ((i + 1) * (j + 1) <= 16) { const unsigned v = (f2sortable(s0[i] + s1[j]) & ~255u) | (unsigned)(i * 16 + j); INS16(L, v); }
                float es[16], sum = 0.f; const float f0 = from_sortable(L[0] & ~255u);
#pragma unroll
                for (int r = 0; r < 16; ++r) { es[r] = __expf(from_sortable(L[r] & ~255u) - f0); sum += es[r]; }
                const float inv = 1.0f / sum; const int tok = c.tid >> 2, hh = (c.tid >> 1) & 1; const size_t ob = (size_t)(t0 + tok) * 128 + (2 * hp + hh) * 16;
#pragma unroll
                for (int r = 0; r < 16; ++r) { const int ij = L[r] & 255u; const int e = (int)(r0[ij >> 4] & 127u) * 128 + (int)(r1[ij & 15] & 127u); EIDX[ob + r] = e; GWT[ob + r] = es[r] * inv; }
            }
        }
    }
    __syncthreads();
}
__device__ __forceinline__ void phase_pgather_u(KP p, int l, size_t hdst) {
    const Ctx c = make_ctx();
    const bf16* HN = (const bf16*)(p->ws + WS_HN); float* X = (float*)(p->ws + WS_X); const int* EIDX = (const int*)(p->ws + WS_EIDX); const float* GWT = (const float*)(p->ws + WS_GW);
    const unsigned char* U8 = p->ws + WS_U; const unsigned char* V8 = p->ws + WS_V; const float* SU = (const float*)(p->ws + WS_SCL); const float* SV = SU + 16384;
    const float* g2 = (const float*)(p->ws + WS_MOD) + (size_t)l * NBATCH * 12288 + 5 * D;
    u32x4 xvn[4]; int e0n = 0, e1n = 0;
    if (c.gw < T) { e0n = EIDX[(size_t)c.gw * 128 + c.lane]; e1n = EIDX[(size_t)c.gw * 128 + 64 + c.lane];
#pragma unroll
        for (int j = 0; j < 2; ++j)
#pragma unroll
            for (int hh = 0; hh < 2; ++hh) xvn[2 * j + hh] = *((const u32x4*)(HN + (size_t)c.gw * D + 1024 * j + 16 * c.lane) + hh); }
    for (int t = c.gw; t < T; t += c.NGW) {
        float xf[32];
#pragma unroll
        for (int q = 0; q < 4; ++q) { const u32x4 w = xvn[q];
            xf[8 * q + 0] = bflo(w.x); xf[8 * q + 1] = bfhi(w.x); xf[8 * q + 2] = bflo(w.y); xf[8 * q + 3] = bfhi(w.y);
            xf[8 * q + 4] = bflo(w.z); xf[8 * q + 5] = bfhi(w.z); xf[8 * q + 6] = bflo(w.w); xf[8 * q + 7] = bfhi(w.w); }
        const int e0 = e0n, e1 = e1n;
        { const int tn = (t + c.NGW < T) ? t + c.NGW : t;
          e0n = EIDX[(size_t)tn * 128 + c.lane]; e1n = EIDX[(size_t)tn * 128 + 64 + c.lane];
#pragma unroll
          for (int j = 0; j < 2; ++j)
#pragma unroll
              for (int hh = 0; hh < 2; ++hh) xvn[2 * j + hh] = *((const u32x4*)(HN + (size_t)tn * D + 1024 * j + 16 * c.lane) + hh); }
        const float gw0 = GWT[(size_t)t * 128 + c.lane], gw1 = GWT[(size_t)t * 128 + 64 + c.lane];
        const float su0 = SU[e0], su1 = SU[e1], sv0 = SV[e0], sv1 = SV[e1];
        float a0 = 0.f, a1 = 0.f;
        u32x4 R[8][2];
#define ROWIDX(e) (((e) < 64) ? __builtin_amdgcn_readlane(e0, (e) & 63) : __builtin_amdgcn_readlane(e1, (e) & 63))
#define LOADROW(base, e, u) do { const int _ia = __builtin_amdgcn_readlane(e0, (e) & 63), _ib = __builtin_amdgcn_readlane(e1, (e) & 63); \
        const u32x4* _rp = (const u32x4*)((base) + (size_t)(((e) < 64) ? _ia : _ib) * 2048) + c.lane; R[u][0] = _rp[0]; R[u][1] = _rp[64]; } while (0)
#define UROW(u, e) do { float p0 = 0.f, p1 = 0.f, p2 = 0.f, p3 = 0.f; \
            _Pragma("unroll") for (int j = 0; j < 2; ++j) { const u32x4 rw = R[u][j]; const unsigned wd[4] = {rw.x, rw.y, rw.z, rw.w}; \
                _Pragma("unroll") for (int k = 0; k < 4; ++k) { const f32x2 lo = __builtin_amdgcn_cvt_pk_f32_fp8((int)wd[k], false), hi = __builtin_amdgcn_cvt_pk_f32_fp8((int)wd[k], true); \
                    p0 += lo.x * xf[16 * j + 4 * k]; p1 += lo.y * xf[16 * j + 4 * k + 1]; p2 += hi.x * xf[16 * j + 4 * k + 2]; p3 += hi.y * xf[16 * j + 4 * k + 3]; } } \
            upart = (p0 + p1) + (p2 + p3); } while (0)
#define UPUT(e) do { const float tot = wave_total(upart); if ((e) < 64) a0 = (c.lane == (e)) ? tot : a0; else a1 = (c.lane == (e) - 64) ? tot : a1; } while (0)
#pragma unroll
        for (int u = 0; u < 8; ++u) LOADROW(U8, u, u);
        float upart;
        for (int eb = 0; eb < 120; eb += 8) {
#pragma unroll
            for (int u = 0; u < 8; ++u) { const int e = eb + u; UROW(u, e); LOADROW(U8, e + 8, u); UPUT(e); }
        }
#pragma unroll
        for (int u = 0; u < 8; ++u) { const int e = 120 + u; UROW(u, e); UPUT(e); }
#undef UROW
#undef UPUT
        const float h0 = gelu_tanh(a0 * su0) * gw0 * sv0, h1 = gelu_tanh(a1 * su1) * gw1 * sv1;
        float* hw = (float*)(p->ws + hdst) + (size_t)t * 128; hw[c.lane] = h0; hw[64 + c.lane] = h1;
#undef LOADROW
#undef ROWIDX
    }
}

__device__ __forceinline__ void phase_pgather_us(KP p, int l, size_t hdst) {
    const Ctx c = make_ctx();
    const bf16* HN = (const bf16*)(p->ws + WS_HN); const int* EIDX = (const int*)(p->ws + WS_EIDX); const float* GWT = (const float*)(p->ws + WS_GW);
    const unsigned char* U8 = p->ws + WS_U; const float* SU = (const float*)(p->ws + WS_SCL); const float* SV = SU + 16384;
    const int eg = c.lane >> 3, pp = c.lane & 7;
    LAS int* wl = (LAS int*)(c.lds + 1024 + c.wave * 4096);
    for (int tg = c.gw; tg < T / 4; tg += c.NGW) { const int tw = 4 * tg;
#pragma unroll
        for (int k = 0; k < 4; ++k) { const size_t tb = (size_t)(tw + k) * 128; wl[128 * k + c.lane] = EIDX[tb + c.lane] << 7; wl[128 * k + 64 + c.lane] = EIDX[tb + 64 + c.lane] << 7; }
        LDS_WAIT();
        float acc[4][16];
#pragma unroll
        for (int k = 0; k < 4; ++k)
#pragma unroll
            for (int i = 0; i < 16; ++i) acc[k][i] = 0.f;
        u32x4 xn[2];
        { const u32x4* xp = (const u32x4*)(HN + (size_t)tw * D + 16 * pp); xn[0] = xp[0]; xn[1] = xp[1]; }
        u32x4 RA[8], RB[8];
#define PU_ISSUE(RR, ubase, k, hf) do { const LAS int* _oi = wls + 128 * (k) + eg + 64 * (hf); _Pragma("unroll") for (int i = 0; i < 8; ++i) RR[i] = *(const u32x4*)((ubase) + ((unsigned)_oi[8 * i] + pp16)); } while (0)
#define PU_CONSUME(RR, k, hf) do { _Pragma("unroll") for (int i = 0; i < 8; ++i) { const unsigned wd[4] = {RR[i].x, RR[i].y, RR[i].z, RR[i].w}; f32x2 q2 = (f32x2){0.f, 0.f}; \
                _Pragma("unroll") for (int r = 0; r < 4; ++r) { const f32x2 lo = __builtin_amdgcn_cvt_pk_f32_fp8((int)wd[r], false), hh = __builtin_amdgcn_cvt_pk_f32_fp8((int)wd[r], true); \
                    q2 = lo * xs2[2 * r] + q2; q2 = hh * xs2[2 * r + 1] + q2; }     \
                float _a = acc[k][8 * (hf) + i] + (q2.x + q2.y); asm volatile("" : "+v"(_a)); acc[k][8 * (hf) + i] = _a; } } while (0)
        LAS int* wls = wl; asm volatile("" : "+v"(wls));
        const unsigned pp16 = 16u * (unsigned)pp;
        PU_ISSUE(RA, U8, 0, 0);
#pragma unroll 1
        for (int s = 0; s < 16; ++s) {
            asm volatile("" : "+v"(wls));
            const unsigned char* ub = U8 + (size_t)s * (16384 * 128);
            const int sn = s < 15 ? s + 1 : 15;
            const unsigned char* ubn = U8 + (size_t)sn * (16384 * 128);
#pragma unroll
            for (int k = 0; k < 4; ++k) {
                f32x2 xs2[8];
                { const u32x4 xa = xn[0], xb = xn[1];
                  xs2[0] = (f32x2){bflo(xa.x), bfhi(xa.x)}; xs2[1] = (f32x2){bflo(xa.y), bfhi(xa.y)}; xs2[2] = (f32x2){bflo(xa.z), bfhi(xa.z)}; xs2[3] = (f32x2){bflo(xa.w), bfhi(xa.w)};
                  xs2[4] = (f32x2){bflo(xb.x), bfhi(xb.x)}; xs2[5] = (f32x2){bflo(xb.y), bfhi(xb.y)}; xs2[6] = (f32x2){bflo(xb.z), bfhi(xb.z)}; xs2[7] = (f32x2){bflo(xb.w), bfhi(xb.w)}; }
                { const u32x4* xp = (const u32x4*)(HN + (size_t)(tw + ((k + 1) & 3)) * D + 128 * (k < 3 ? s : sn) + 16 * pp); xn[0] = xp[0]; xn[1] = xp[1]; }
                PU_ISSUE(RB, ub, k, 1); __builtin_amdgcn_sched_barrier(0);
                PU_CONSUME(RA, k, 0); __builtin_amdgcn_sched_barrier(0);
                if (k < 3) PU_ISSUE(RA, ub, k + 1, 0); else PU_ISSUE(RA, ubn, 0, 0);
                __builtin_amdgcn_sched_barrier(0);
                PU_CONSUME(RB, k, 1); __builtin_amdgcn_sched_barrier(0);
            }
        }
#undef PU_ISSUE
#undef PU_CONSUME
        int ev[4][2]; float suv[4][2], svv[4][2], gwv[4][2];
#pragma unroll
        for (int k = 0; k < 4; ++k) { ev[k][0] = wl[128 * k + c.lane] >> 7; ev[k][1] = wl[128 * k + 64 + c.lane] >> 7; }
        LDS_WAIT(); asm volatile("" ::: "memory");
#pragma unroll
        for (int k = 0; k < 4; ++k)
#pragma unroll
            for (int hf = 0; hf < 2; ++hf) { const int e = ev[k][hf]; suv[k][hf] = SU[e]; svv[k][hf] = SV[e]; gwv[k][hf] = GWT[(size_t)(tw + k) * 128 + 64 * hf + c.lane]; }
        asm volatile("" ::: "memory");
#pragma unroll
        for (int k = 0; k < 4; ++k)
#pragma unroll
            for (int i = 0; i < 16; ++i) { float q = acc[k][i];
                q += __builtin_bit_cast(float, __builtin_amdgcn_mov_dpp(__builtin_bit_cast(int, q), 0xB1, 0xf, 0xf, true));
                q += __builtin_bit_cast(float, __builtin_amdgcn_mov_dpp(__builtin_bit_cast(int, q), 0x4E, 0xf, 0xf, true));
                q += __builtin_bit_cast(float, __builtin_amdgcn_mov_dpp(__builtin_bit_cast(int, q), 0x141, 0xf, 0xf, true));
                if (pp == 0) ((LAS float*)wl)[128 * k + eg + 8 * i] = q; }
        LDS_WAIT(); asm volatile("" ::: "memory");
        float hv[4][2];
#pragma unroll
        for (int k = 0; k < 4; ++k)
#pragma unroll
            for (int hf = 0; hf < 2; ++hf) { const float a = ((const LAS float*)wl)[128 * k + 64 * hf + c.lane]; hv[k][hf] = gelu_tanh(a * suv[k][hf]) * gwv[k][hf] * svv[k][hf]; }
#pragma unroll
        for (int k = 0; k < 4; ++k) { float* hw = (float*)(p->ws + hdst) + (size_t)(tw + k) * 128; hw[c.lane] = hv[k][0]; hw[64 + c.lane] = hv[k][1]; }
        LDS_WAIT();
    }
}
__device__ __forceinline__ void phase_pgather_v(KP p, int l, int qoff) {
    const Ctx c = make_ctx();
    const int* EIDX = (const int*)(p->ws + WS_EIDX); const float* H = (const float*)(p->ws + WS_GW); const unsigned char* V8 = p->ws + WS_V; float* YP = (float*)(p->ws + WS_YP);
    int* qv = (int*)(p->ws + WS_QV) + l * 16 + qoff; LAS int* sblk = (LAS int*)c.lds;
    const int xcc = (int)(xb_xcc_id() & 7u);
    for (int round = 0; round < 18; ++round) {
        int sl;
        if (round < 2) sl = xcc + 8 * round;
        else { if (round == 2) { __syncthreads(); if (c.tid < 16) sblk[8 + c.tid] = __hip_atomic_load(qv + c.tid, __ATOMIC_RELAXED, __HIP_MEMORY_SCOPE_AGENT); __syncthreads(); }
               sl = (xcc + 1 + (round - 2)) & 15; if (sblk[8 + sl] >= T / 64) continue; }
        __syncthreads(); if (c.tid == 0) sblk[0] = atomicAdd(qv + sl, 1); __syncthreads();
        int blk = sblk[0];
        while (blk < T / 64) {
            int nxt = 0; if (c.tid == 0) nxt = atomicAdd(qv + sl, 1);
            const int eg = c.lane >> 3, pp = c.lane & 7;
            const unsigned char* vb = V8 + (size_t)sl * (16384 * 128) + 16 * pp;
            LAS int* wl = (LAS int*)(c.lds + 1024 + c.wave * 8192);
            const int tw = blk * 64 + c.wave * 8;
#pragma unroll
            for (int k = 0; k < 8; ++k) { const size_t tb = (size_t)(tw + k) * 128;
                wl[256 * k + c.lane] = EIDX[tb + c.lane] << 7; wl[256 * k + 64 + c.lane] = EIDX[tb + 64 + c.lane] << 7;
                wl[256 * k + 128 + c.lane] = __builtin_bit_cast(int, H[tb + c.lane]); wl[256 * k + 192 + c.lane] = __builtin_bit_cast(int, H[tb + 64 + c.lane]); }
            LDS_WAIT();
            u32x4 RA[8], RB[8];
#define PV_ISSUE(RR, k, hf) do { const LAS int* _oi = wl + 256 * (k) + eg + 64 * (hf); _Pragma("unroll") for (int i = 0; i < 8; ++i) RR[i] = *(const u32x4*)(vb + (unsigned)_oi[8 * i]); } while (0)
#define PV_CONSUME(RR, k, hf) do { const LAS float* _oh = (const LAS float*)(wl + 256 * (k) + 128 + eg + 64 * (hf)); \
                _Pragma("unroll") for (int i = 0; i < 8; ++i) { const float he = _oh[8 * i]; const unsigned wd[4] = {RR[i].x, RR[i].y, RR[i].z, RR[i].w}; \
                    _Pragma("unroll") for (int r = 0; r < 4; ++r) { const f32x2 lo = __builtin_amdgcn_cvt_pk_f32_fp8((int)wd[r], false), hh = __builtin_amdgcn_cvt_pk_f32_fp8((int)wd[r], true); \
                        y[4 * r] += he * lo.x; y[4 * r + 1] += he * lo.y; y[4 * r + 2] += he * hh.x; y[4 * r + 3] += he * hh.y; } } } while (0)
            PV_ISSUE(RA, 0, 0);
#pragma unroll 1
            for (int k = 0; k < 8; ++k) {
                float y[16];
#pragma unroll
                for (int q = 0; q < 16; ++q) y[q] = 0.f;
                PV_ISSUE(RB, k, 1);
                PV_CONSUME(RA, k, 0);
                if (k + 1 < 8) PV_ISSUE(RA, k + 1, 0);
                PV_CONSUME(RB, k, 1);
#pragma unroll
                for (int q = 0; q < 16; ++q) { y[q] += __shfl_xor(y[q], 8); y[q] += __shfl_xor(y[q], 16); y[q] += __shfl_xor(y[q], 32); }
                if (eg == 0) { f32x4* yo = (f32x4*)(YP + (size_t)(tw + k) * D + 128 * sl + 16 * pp);
                    yo[0] = (f32x4){y[0], y[1], y[2], y[3]}; yo[1] = (f32x4){y[4], y[5], y[6], y[7]}; yo[2] = (f32x4){y[8], y[9], y[10], y[11]}; yo[3] = (f32x4){y[12], y[13], y[14], y[15]}; }
            }
#undef PV_ISSUE
#undef PV_CONSUME
            __syncthreads(); if (c.tid == 0) sblk[0] = nxt; __syncthreads(); blk = sblk[0];
        }
    }
    __syncthreads();
}
__device__ __forceinline__ void phase_pgather_vs(KP p, int l, size_t ydst) {
    const Ctx c = make_ctx();
    const int* EIDX = (const int*)(p->ws + WS_EIDX); const float* H = (const float*)(p->ws + WS_GW); const unsigned char* V8 = p->ws + WS_V; float* YP = (float*)(p->ws + ydst);
    const int eg = c.lane >> 3, pp = c.lane & 7; const unsigned pp16 = 16u * (unsigned)pp;
    const bool b3 = (c.lane & 8) != 0, b4 = (c.lane & 16) != 0, b5 = (c.lane & 32) != 0;
    const int ocol = 16 * pp + (b5 ? 8 : 0) + (b4 ? 4 : 0) + (b3 ? 2 : 0);
    LAS int* wl = (LAS int*)(c.lds + 1024 + c.wave * 4096);
    for (int tg = c.gw; tg < T / 4; tg += c.NGW) { const int tw = 4 * tg;
#pragma unroll
        for (int k = 0; k < 4; ++k) { const size_t tb = (size_t)(tw + k) * 128;
            wl[256 * k + c.lane] = EIDX[tb + c.lane] << 7; wl[256 * k + 64 + c.lane] = EIDX[tb + 64 + c.lane] << 7;
            wl[256 * k + 128 + c.lane] = __builtin_bit_cast(int, H[tb + c.lane]); wl[256 * k + 192 + c.lane] = __builtin_bit_cast(int, H[tb + 64 + c.lane]); }
        LDS_WAIT();
        u32x4 RA[8], RB[8];
#define PV_ISSUE(RR, ubase, k, hf) do { const LAS int* _oi = wl + 256 * (k) + eg + 64 * (hf); _Pragma("unroll") for (int i = 0; i < 8; ++i) RR[i] = *(const u32x4*)((ubase) + ((unsigned)_oi[8 * i] + pp16)); } while (0)
#define PV_CONSUME(RR, k, hf) do { const LAS float* _oh = (const LAS float*)(wl + 256 * (k) + 128 + eg + 64 * (hf)); \
            _Pragma("unroll") for (int i = 0; i < 8; ++i) { const float he = _oh[8 * i]; const f32x2 he2 = (f32x2){he, he}; const unsigned wd[4] = {RR[i].x, RR[i].y, RR[i].z, RR[i].w}; \
                _Pragma("unroll") for (int r = 0; r < 4; ++r) { const f32x2 lo = __builtin_amdgcn_cvt_pk_f32_fp8((int)wd[r], false), hh = __builtin_amdgcn_cvt_pk_f32_fp8((int)wd[r], true); \
                    y2[2 * r] = lo * he2 + y2[2 * r]; y2[2 * r + 1] = hh * he2 + y2[2 * r + 1]; } } } while (0)
        PV_ISSUE(RA, V8, 0, 0);
#pragma unroll 1
        for (int it = 0; it < 64; ++it) { const int s = it >> 2, k = it & 3;
            const int itn = it < 63 ? it + 1 : 63, sn = itn >> 2, kn = itn & 3;
            const unsigned char* vb = V8 + (size_t)s * (16384 * 128); const unsigned char* vbn = V8 + (size_t)sn * (16384 * 128);
            f32x2 y2[8];
#pragma unroll
            for (int q = 0; q < 8; ++q) y2[q] = (f32x2){0.f, 0.f};
            PV_ISSUE(RB, vb, k, 1);
            PV_CONSUME(RA, k, 0);
            PV_ISSUE(RA, vbn, kn, 0);
            PV_CONSUME(RB, k, 1);
            f32x2 a4[4], a2[2], a1;
#pragma unroll
            for (int q = 0; q < 4; ++q) { const f32x2 keep = b5 ? y2[4 + q] : y2[q], send = b5 ? y2[q] : y2[4 + q];
                a4[q] = keep + (f32x2){__shfl_xor(send.x, 32), __shfl_xor(send.y, 32)}; }
#pragma unroll
            for (int q = 0; q < 2; ++q) { const f32x2 keep = b4 ? a4[2 + q] : a4[q], send = b4 ? a4[q] : a4[2 + q];
                a2[q] = keep + (f32x2){__shfl_xor(send.x, 16), __shfl_xor(send.y, 16)}; }
            { const f32x2 keep = b3 ? a2[1] : a2[0], send = b3 ? a2[0] : a2[1];
              a1 = keep + (f32x2){__shfl_xor(send.x, 8), __shfl_xor(send.y, 8)}; }
            *(f32x2*)(YP + (size_t)(tw + k) * D + 128 * s + ocol) = a1;
        }
#undef PV_ISSUE
#undef PV_CONSUME
        LDS_WAIT();
    }
}
__device__ __forceinline__ void phase_pgather_e(KP p, int l) {
    const Ctx c = make_ctx();
    float* X = (float*)(p->ws + WS_X); const float* YP = (const float*)(p->ws + WS_YP);
    const float* g2 = (const float*)(p->ws + WS_MOD) + (size_t)l * NBATCH * 12288 + 5 * D;
    asm volatile("s_waitcnt vmcnt(0)" ::: "memory");
    for (int tq = 4 * c.gw; tq < T; tq += ((tq & 3) == 3) ? 4 * c.NGW - 3 : 1) { const int t = tq;
        float y[32];
#pragma unroll
        for (int j = 0; j < 2; ++j)
#pragma unroll
            for (int q = 0; q < 4; ++q) { const f32x4 yy = ((const f32x4*)(YP + (size_t)t * D))[256 * j + 4 * c.lane + q]; y[16 * j + 4 * q] = yy[0]; y[16 * j + 4 * q + 1] = yy[1]; y[16 * j + 4 * q + 2] = yy[2]; y[16 * j + 4 * q + 3] = yy[3]; }
        f32x4* xr = (f32x4*)(X + (size_t)t * D); const f32x4* gp = (const f32x4*)(g2 + (size_t)(t >> 11) * 12288);
        f32x4 xn[8]; float ss = 0.f;
#pragma unroll
        for (int j = 0; j < 2; ++j)
#pragma unroll
            for (int q = 0; q < 4; ++q) { const int i4 = 256 * j + 4 * c.lane + q; const f32x4 yy = (f32x4){y[16 * j + 4 * q], y[16 * j + 4 * q + 1], y[16 * j + 4 * q + 2], y[16 * j + 4 * q + 3]};
                const f32x4 v = xr[i4] + gp[i4] * yy; xn[4 * j + q] = v; ss += (v[0] * v[0] + v[1] * v[1]) + (v[2] * v[2] + v[3] * v[3]); }
        const float rstd = 1.0f / sqrtf(wave_total(ss) * (1.0f / D) + EPS);
        if (l == 0) {
            const float* mod1 = (const float*)(p->ws + WS_MOD) + (size_t)(NBATCH + (t >> 11)) * 12288;
            const f32x4* n1 = (const f32x4*)(p->norm1_g + D); const f32x4* shp = (const f32x4*)mod1; const f32x4* scp = (const f32x4*)(mod1 + D);
            u32x2* ho = (u32x2*)((bf16*)(p->ws + WS_HN) + (size_t)t * D); float am8 = 0.f;
            f32x4 n1v[8], scv[8], shv[8];
#pragma unroll
            for (int j = 0; j < 2; ++j)
#pragma unroll
                for (int q = 0; q < 4; ++q) { const int i4 = 256 * j + 4 * c.lane + q; n1v[4 * j + q] = n1[i4]; scv[4 * j + q] = scp[i4]; shv[4 * j + q] = shp[i4]; }
#pragma unroll
            for (int j = 0; j < 2; ++j)
#pragma unroll
                for (int q = 0; q < 4; ++q) { const int i4 = 256 * j + 4 * c.lane + q; xr[i4] = xn[4 * j + q];
                    const f32x4 yv = xn[4 * j + q] * rstd * n1v[4 * j + q] * (scv[4 * j + q] + 1.0f) + shv[4 * j + q]; u32x2 w; w.x = pk2(yv[0], yv[1]); w.y = pk2(yv[2], yv[3]); ho[i4] = w;
                    xn[4 * j + q] = yv; am8 = fmaxf(am8, fmaxf(fmaxf(fabsf(yv[0]), fabsf(yv[1])), fmaxf(fabsf(yv[2]), fabsf(yv[3])))); }
            {
                am8 = wave_amax(am8); const float q8 = am8 > 0.f ? 240.0f / am8 : 1.0f; unsigned* o1 = (unsigned*)(p->ws + WS_HN8 + (size_t)t * D);
#pragma unroll
                for (int j = 0; j < 2; ++j)
#pragma unroll
                    for (int q = 0; q < 4; ++q) { const f32x4 yv = xn[4 * j + q]; int w = 0; w = __builtin_amdgcn_cvt_pk_fp8_f32(yv[0] * q8, yv[1] * q8, w, false); w = __builtin_amdgcn_cvt_pk_fp8_f32(yv[2] * q8, yv[3] * q8, w, true); o1[256 * j + 4 * c.lane + q] = (unsigned)w; }
                if (c.lane == 0) ((float*)(p->ws + WS_RS))[t] = am8 > 0.f ? am8 * (1.0f / 240.0f) : 1.0f; }
        } else {
            const f32x4* fg = (const f32x4*)p->final_g; f32x4* oo = (f32x4*)(p->out + (size_t)t * D);
            f32x4 fgv[8];
#pragma unroll
            for (int j = 0; j < 2; ++j)
#pragma unroll
                for (int q = 0; q < 4; ++q) fgv[4 * j + q] = fg[256 * j + 4 * c.lane + q];
#pragma unroll
            for (int j = 0; j < 2; ++j)
#pragma unroll
                for (int q = 0; q < 4; ++q) { const int i4 = 256 * j + 4 * c.lane + q; oo[i4] = xn[4 * j + q] * rstd * fgv[4 * j + q]; }
        }
    }
}

constexpr int PH_PER_LAYER = 13, PH_TOTAL = 2 * PH_PER_LAYER;
__global__ void __launch_bounds__(NTHR, 2) hse_fwd(P p_unused) {
    extern __shared__ __attribute__((aligned(16))) unsigned char lds_raw[];
    {
        LAS unsigned char* lds = (LAS unsigned char*)lds_raw;
        for (int u = threadIdx.x; u < (LDS_BYTES - LDSCTL_OFF) / 4; u += NTHR) ((LAS unsigned*)(lds + LDSCTL_OFF))[u] = 0u;
        __syncthreads();
    }
#if MK_ONE_LAUNCH
    XcdBarrier bar = xcd_barrier_post((unsigned*)(kargs()->ws + WS_CTL) + CW_BAR, (volatile LAS unsigned*)((LAS unsigned char*)lds_raw + LDSCTL_OFF) + 8);
#define GRID_BAR() xcd_barrier(bar)
#else
#define GRID_BAR() do {} while (0)
#endif
    const int lo = kargs()->ph_lo, hi = kargs()->ph_hi;
#define IN(k) (lo <= (k) && (k) < hi)
#define SEAM(k) do { if (IN(k) && IN((k) + 1)) GRID_BAR(); } while (0)
#define WSP(q, off) ((q)->ws + (off))
#define MODL(q, l) ((const float*)((q)->ws + WS_MOD) + (size_t)(l) * NBATCH * 12288)
#define XIN(q, l) (((l) == 0) ? (q)->x : (const float*)((q)->ws + WS_X))
    for (int l = 0; l < NLAYER; ++l) {
        const int pb = l * PH_PER_LAYER;
        if (IN(pb + 0)) { asm volatile("; MKPH 0" ::: "memory"); phase_prep(kargs(), l); if (l == 0) gate_col_amax(kargs()); else gate_transpose_f8(kargs(), l); if (PROBE_PHASE == 0) phase_prep(kargs(), l); } SEAM(pb + 0);
        if (IN(pb + 1) && l == 0) { asm volatile("; MKPH 1" ::: "memory"); KP q = kargs(); phase_norm_mod<true>(XIN(q, l), q->norm1_g + (size_t)l * D, MODL(q, l) + 0 * D, MODL(q, l) + 1 * D, (bf16*)WSP(q, WS_HN), WSP(q, WS_HN8), (float*)WSP(q, WS_RS)); gate_transpose_f8(kargs(), l); } if (l == 0) SEAM(pb + 1);
        if (IN(pb + 2)) { asm volatile("; MKPH 2" ::: "memory");
#if NAIVE_GEMM
            naive_proj(kargs(), l);
#else
            KP q = kargs(); LAS unsigned char* lds = (LAS unsigned char*)lds_raw;
            { pg8::Gemm g{(const bf16*)WSP(q, WS_HN), (const bf16*)WSP(q, WS_WIN), T, NPROJ_BF, D, 0, 0}; pg8::StaticOrder S; S.init(T, NPROJ_BF, (int)gridDim.x, (int)blockIdx.x);
              pg8::EpiBf16 E{(bf16*)WSP(q, WS_PROJ) + BF_LO, NPROJ};
              pg8::gemm_phase<pg8::EpiBf16, pg8::StaticOrder, true, true>(lds, g, S, E); if (PROBE_PHASE == 2) { pg8::gemm_phase<pg8::EpiBf16, pg8::StaticOrder, true, true>(lds, g, S, E); } }
            { KP q2 = kargs();
              pg8::Gemm g{(const bf16*)WSP(q2, WS_HN8), (const bf16*)WSP(q2, WS_WG8), T, N8, D, 0, 0}; pg8::F8BalOrder S; S.so.init(T, N8, (int)gridDim.x, (int)gridDim.x - 1 - (int)blockIdx.x); S.c = (int)blockIdx.x;
              pg8::EpiF8 E{(bf16*)WSP(q2, WS_PROJ), (const float*)WSP(q2, WS_RS), (const float*)WSP(q2, WS_CSD), (const float*)WSP(q2, WS_ROPE)};
              pg8::gemm_phase<pg8::EpiF8, pg8::F8BalOrder, true, true, true>(lds, g, S, E); if (PROBE_PHASE == 2) { pg8::gemm_phase<pg8::EpiF8, pg8::F8BalOrder, true, true, true>(lds, g, S, E); } }
#endif
        } SEAM(pb + 2);
        if (IN(pb + 3)) { asm volatile("; MKPH 3" ::: "memory"); phase_conv(kargs(), l); phase_sg(kargs(), l); phase_band(kargs(), l); phase_d1(kargs(), l);
            if (PROBE_PHASE == 30) phase_conv(kargs(), l); if (PROBE_PHASE == 31) phase_sg(kargs(), l); if (PROBE_PHASE == 32) phase_band(kargs(), l); if (PROBE_PHASE == 33) phase_d1(kargs(), l); } SEAM(pb + 3);
        if (IN(pb + 4)) { asm volatile("; MKPH 4" ::: "memory"); phase_d2(kargs(), l); if (PROBE_PHASE == 4) phase_d2(kargs(), l); } SEAM(pb + 4);
        if (IN(pb + 5)) { asm volatile("; MKPH 5" ::: "memory");
#if NAIVE_GEMM
            naive_branch(kargs(), l);
#else
            KP q = kargs(); LAS unsigned char* lds = (LAS unsigned char*)lds_raw;
            pg8::Gemm g{(const bf16*)WSP(q, WS_OBR), (const bf16*)WSP(q, WS_WB), T, D, BRW, (size_t)T * BRW * 2, (size_t)D * BRW * 2};
            pg8::BatchOrder<4> S; S.so.init(T, D, (int)gridDim.x, (int)blockIdx.x);
            pg8::EpiBranch E{(bf16*)WSP(q, WS_Y), (const bf16*)WSP(q, WS_PROJ)};
            pg8::gemm_phase<pg8::EpiBranch, pg8::BatchOrder<4>, true, true>(lds, g, S, E); if (PROBE_PHASE == 5) { pg8::gemm_phase<pg8::EpiBranch, pg8::BatchOrder<4>, true, true>(lds, g, S, E); }
#endif
        } SEAM(pb + 5);
        if (IN(pb + 6)) { asm volatile("; MKPH 6" ::: "memory");
#if NAIVE_GEMM
            { KP q = kargs(); naive_wo(q, l, XIN(q, l)); }
#else
            KP q = kargs(); LAS unsigned char* lds = (LAS unsigned char*)lds_raw;
            pg8::Gemm g{(const bf16*)WSP(q, WS_Y), (const bf16*)WSP(q, WS_WO), T, D, D, 0, 0}; pg8::StaticOrder S; S.init(T, D, (int)gridDim.x, (int)blockIdx.x);
            pg8::EpiResid E{XIN(q, l), (float*)WSP(q, WS_X), MODL(q, l) + 2 * D};
            pg8::gemm_phase<pg8::EpiResid, pg8::StaticOrder, true, true>(lds, g, S, E);
#endif
        } SEAM(pb + 6);
        if (IN(pb + 7)) { asm volatile("; MKPH 7" ::: "memory"); KP q = kargs(); phase_norm_mod<false>((const float*)WSP(q, WS_X), q->norm2_g + (size_t)l * D, MODL(q, l) + 3 * D, MODL(q, l) + 4 * D, (bf16*)WSP(q, WS_HN), nullptr, nullptr); } SEAM(pb + 7);
        if (IN(pb + 8)) { asm volatile("; MKPH 8" ::: "memory");
#if NAIVE_GEMM
            naive_wq(kargs(), l);
#else
            KP q = kargs(); LAS unsigned char* lds = (LAS unsigned char*)lds_raw;
            pg8::Gemm g{(const bf16*)WSP(q, WS_HN), (const bf16*)WSP(q, WS_WQ), T, D, D, 0, 0}; pg8::StaticOrder S; S.init(T, D, (int)gridDim.x, (int)blockIdx.x);
            pg8::EpiBf16 E{(bf16*)WSP(q, WS_QP), D};
            pg8::gemm_phase<pg8::EpiBf16, pg8::StaticOrder, true, true>(lds, g, S, E); if (PROBE_PHASE == 8) { pg8::gemm_phase<pg8::EpiBf16, pg8::StaticOrder, true, true>(lds, g, S, E); }
#endif
        } SEAM(pb + 8);
        if (IN(pb + 9)) { asm volatile("; MKPH 9" ::: "memory"); phase_psel(kargs(), l); if (PROBE_PHASE == 9) phase_psel(kargs(), l); } SEAM(pb + 9);
        if (IN(pb + 10)) { asm volatile("; MKPH 10" ::: "memory"); phase_pgather_us(kargs(), l, WS_GW); if (PROBE_PHASE == 10) phase_pgather_us(kargs(), l, WS_SCI); } SEAM(pb + 10);
        if (IN(pb + 11)) { asm volatile("; MKPH 11" ::: "memory"); phase_pgather_vs(kargs(), l, WS_YP); if (PROBE_PHASE == 11) phase_pgather_vs(kargs(), l, WS_YP); }
        if (IN(pb + 12)) { asm volatile("; MKPH 12" ::: "memory"); phase_pgather_e(kargs(), l); } SEAM(pb + 12);
    }
#undef IN
#undef SEAM
}

extern "C" void kernel_launch(void* const* d_in, const int* in_sizes, int n_in, void* d_out, int out_size, void* d_ws, size_t ws_size, hipStream_t stream) {
    static int grid = 0;
    if (grid == 0) {
        if (n_in != 19 || out_size != T * D || ws_size < WS_END) { fprintf(stderr, "kernel_launch: unexpected problem (n_in %d out %d ws %zu)\n", n_in, out_size, ws_size); grid = -1; return; }
        int dev = 0, cus = 0, per_cu = 0;
        if (hipGetDevice(&dev) != hipSuccess || hipDeviceGetAttribute(&cus, hipDeviceAttributeMultiprocessorCount, dev) != hipSuccess) { grid = -1; return; }
        if (hipFuncSetAttribute((const void*)hse_fwd, hipFuncAttributeMaxDynamicSharedMemorySize, LDS_BYTES) != hipSuccess) { fprintf(stderr, "kernel_launch: hipFuncSetAttribute failed\n"); grid = -1; return; }
        if (hipOccupancyMaxActiveBlocksPerMultiprocessor(&per_cu, (const void*)hse_fwd, NTHR, LDS_BYTES) != hipSuccess || per_cu < 1) { fprintf(stderr, "kernel_launch: occupancy query says %d\n", per_cu); }
        (void)hipGetLastError();
        grid = cus;
    }
    if (grid < 0) return;
    if (hipMemsetAsync((char*)d_ws + WS_CTL, 0, CTL_ZERO_BYTES, stream) != hipSuccess) return;
    P p{};
    p.x = (const float*)d_in[0]; p.c = (const float*)d_in[1]; p.ada_w = (const float*)d_in[2]; p.ada_b = (const float*)d_in[3]; p.norm1_g = (const float*)d_in[4]; p.norm2_g = (const float*)d_in[5];
    p.w_in = (const float*)d_in[6]; p.conv_w = (const float*)d_in[7]; p.sg_norm_g = (const float*)d_in[8]; p.sg_w = (const float*)d_in[9]; p.sg_b = (const float*)d_in[10]; p.rel_bias = (const float*)d_in[11];
    p.w_branch = (const float*)d_in[12]; p.w_o = (const float*)d_in[13]; p.peer_wq = (const float*)d_in[14]; p.peer_keys = (const float*)d_in[15]; p.peer_u = (const float*)d_in[16]; p.peer_v = (const float*)d_in[17]; p.final_g = (const float*)d_in[18];
    p.out = (float*)d_out; p.ws = (unsigned char*)d_ws;
#if MK_ONE_LAUNCH
    p.ph_lo = 0; p.ph_hi = PH_TOTAL;
    hipLaunchKernelGGL(hse_fwd, dim3(grid), dim3(NTHR), LDS_BYTES, stream, p);
#else
    for (int ph = 0; ph < PH_TOTAL; ++ph) { p.ph_lo = ph; p.ph_hi = ph + 1; hipLaunchKernelGGL(hse_fwd, dim3(grid), dim3(NTHR), LDS_BYTES, stream, p); }
#endif
}
```

```cpp
#include <hip/hip_runtime.h>
#include <cstdint>
#include <cstdio>

#ifndef MK_ONE_LAUNCH
#define MK_ONE_LAUNCH 1
#endif
#ifndef PROBE_PHASE
#define PROBE_PHASE -1
#endif
#ifndef NAIVE_GEMM
#define NAIVE_GEMM 0
#endif

#define LAS __attribute__((address_space(3)))
#define GAS __attribute__((address_space(1)))
typedef unsigned short bf16;
typedef float f32x4 __attribute__((ext_vector_type(4)));
typedef float f32x2 __attribute__((ext_vector_type(2)));
typedef short bf16x8 __attribute__((ext_vector_type(8)));
typedef unsigned u32x4 __attribute__((ext_vector_type(4)));
typedef unsigned u32x2 __attribute__((ext_vector_type(2)));

constexpr int T = 16384, D = 2048, SEQ = 2048, NBATCH = 8, NLAYER = 2;
constexpr int PIN = 14928, NPROJ = 15104, NGATE = 8192;
constexpr int F8_LO = 5632, N8 = F8_LO + NGATE;
constexpr int BF_LO = 5632, NPROJ_BF = 1280;
constexpr int PIN_GATE0 = 6736;
constexpr int OFF_A = 0, OFF_SG = 1536, OFF_BAND = 2560, OFF_DSA = 4096, OFF_QI = 5632, OFF_KI = 6656, OFF_WI = 6720, OFF_GATE = 6912;
constexpr int BRW = 512;
constexpr float EPS = 1e-6f;
constexpr int NWAVES = 8, NTHR = 512;

constexpr size_t MiB = 1u << 20;
constexpr size_t WS_CTL = 0, CTL_ZERO_BYTES = 1 * MiB;
constexpr size_t WS_MOD = 1 * MiB;
constexpr size_t WS_ROPE = 2 * MiB;
constexpr size_t WS_WIN = 4 * MiB;
constexpr size_t WS_WB = 63 * MiB;
constexpr size_t WS_WO = 71 * MiB;
constexpr size_t WS_WQ = 79 * MiB;
constexpr size_t WS_KEYS = 87 * MiB;
constexpr size_t WS_U = 88 * MiB, WS_V = 152 * MiB;
constexpr size_t WS_SCL = 87 * MiB + 512 * 1024;
constexpr size_t WS_HN8 = 120 * MiB;
constexpr size_t WS_WG8 = 184 * MiB;
constexpr size_t WS_CSD = 87 * MiB + 704 * 1024;
constexpr size_t WS_RS = 87 * MiB + 640 * 1024;
constexpr size_t WS_CS = WS_CTL + 128 * 1024;
constexpr size_t WS_X = 216 * MiB;
constexpr size_t WS_HN = 344 * MiB;
constexpr size_t WS_OBR = 408 * MiB;
constexpr size_t WS_Y = 472 * MiB;
constexpr size_t WS_MASK = 536 * MiB;
constexpr size_t WS_EIDX = 540 * MiB, WS_GW = 548 * MiB;
constexpr size_t WS_PROJ = 556 * MiB;
constexpr size_t WS_QP = WS_PROJ;
constexpr size_t WS_YP = WS_PROJ + 64 * MiB;
constexpr size_t WS_QV = WS_CTL + 384 * 1024;
constexpr size_t WS_SC = WS_PROJ + 64 * MiB;
constexpr size_t WS_SCI = WS_PROJ + 192 * MiB;
constexpr size_t WS_END = 1028 * MiB;
constexpr int CW_BAR = 4096;

constexpr int RING_BYTES = 131072;
constexpr int LDS_BYTES = 163840;
constexpr int LDSCTL_OFF = LDS_BYTES - 256;

__device__ __forceinline__ float bf2f(bf16 b) { return __uint_as_float(((unsigned)b) << 16); }
__device__ __forceinline__ unsigned f2bf(float f) { unsigned u = __float_as_uint(f); return (u + 0x7fffu + ((u >> 16) & 1u)) >> 16; }
__device__ __forceinline__ unsigned pk2(float lo, float hi) { return f2bf(lo) | (f2bf(hi) << 16); }
__device__ __forceinline__ float bflo(unsigned w) { return __uint_as_float(w << 16); }
__device__ __forceinline__ float bfhi(unsigned w) { return __uint_as_float(w & 0xffff0000u); }
#define DPP_ADD(v, ctl, rmask, bc) (v) += __builtin_bit_cast(float, __builtin_amdgcn_update_dpp(0, __builtin_bit_cast(int, (v)), (ctl), (rmask), 0xf, (bc)))
__device__ __forceinline__ float wave_total(float v) {
    DPP_ADD(v, 0x111, 0xf, true); DPP_ADD(v, 0x112, 0xf, true); DPP_ADD(v, 0x114, 0xf, true); DPP_ADD(v, 0x118, 0xf, true);
    DPP_ADD(v, 0x142, 0xa, false); DPP_ADD(v, 0x143, 0xc, false);
    return __builtin_bit_cast(float, __builtin_amdgcn_readlane(__builtin_bit_cast(int, v), 63));
}
__device__ __forceinline__ float wave_sum(float v) { return wave_total(v); }
#define DPP_MAX(v, ctl, rmask, bc) (v) = fmaxf((v), __builtin_bit_cast(float, __builtin_amdgcn_update_dpp(0, __builtin_bit_cast(int, (v)), (ctl), (rmask), 0xf, (bc))))
__device__ __forceinline__ float wave_amax(float v) {
    DPP_MAX(v, 0x111, 0xf, true); DPP_MAX(v, 0x112, 0xf, true); DPP_MAX(v, 0x114, 0xf, true); DPP_MAX(v, 0x118, 0xf, true);
    DPP_MAX(v, 0x142, 0xa, false); DPP_MAX(v, 0x143, 0xc, false);
    return __builtin_bit_cast(float, __builtin_amdgcn_readlane(__builtin_bit_cast(int, v), 63));
}
__device__ __forceinline__ float wave_max(float v) {
#pragma unroll
    for (int o = 1; o < 64; o <<= 1) v = fmaxf(v, __shfl_xor(v, o));
    return v;
}
#define LDS_WAIT() asm volatile("s_waitcnt lgkmcnt(0)" ::: "memory")

__host__ __device__ __forceinline__ int win_src_col(int j) {
    if (j < 4096) return j;
    if (j < 5120) { const int base = j & ~127, p = j & 127; return base + ((p & 1) ? 64 + (p >> 1) : (p >> 1)); }
    if (j < 6736) return j;
    if (j < OFF_GATE) return -1;
    return j - (OFF_GATE - 6736);
}


__host__ __device__ __forceinline__ int f8_src_col(int j8) {
    if (j8 < F8_LO) return win_src_col(j8);
    const int g = j8 - F8_LO, j = g >> 8, c = g & 255, br = 2 * (c >> 7) + ((c >> 2) & 1), ch = 64 * j + 16 * ((c >> 5) & 3) + 4 * ((c >> 3) & 3) + (c & 3);
    return PIN_GATE0 + br * D + ch;
}

namespace pg8 {
#define PG8_LAS __attribute__((address_space(3)))
typedef unsigned short bf16_t;
constexpr int BM = 256, BK = 64, HALF = 128, HTB = HALF * BK * 2, STAGE_BYTES = 8 * HTB, NXCD = 8, WGM = 2;
__host__ __device__ __forceinline__ int lds_byte(int r, int c) { const int st = (r >> 4) * 2 + (c >> 5), rr = r & 15, cc = c & 31, ob = rr * 64 + cc * 2; return st * 1024 + (ob ^ (((ob >> 9) & 1) << 5)); }
__host__ __device__ __forceinline__ void stage_rc(int b, int& R, int& C) { const int st = b / 1024, sb = b % 1024, swz = sb ^ (((sb >> 9) & 1) << 5); R = (st >> 1) * 16 + swz / 64; C = (st & 1) * 32 + (swz % 64) / 2; }
__host__ __device__ __forceinline__ int perm32(int rho) { const int n = rho >> 4, i = rho & 15; return 8 * (i >> 2) + 4 * n + (i & 3); }

struct Unit { int pm, pn, pz; };
struct Gemm { const bf16_t* A; const bf16_t* Bt; int M, N, K; size_t zA, zB; };

struct StaticOrder {
    int nM, nN, nwg, G, c;
    __host__ __device__ void init(int M, int N, int G_, int c_) { nM = M / BM; nN = N / BM; nwg = nM * nN; G = G_; c = c_; }
    __host__ __device__ bool next(int i, Unit& u) const {
        const long L = (long)i * G + c; if (L >= nwg) return false;
        int wgid = (int)L; { const int q = nwg / NXCD, r = nwg % NXCD, xcd = wgid % NXCD, off = wgid / NXCD; wgid = (xcd < r ? xcd * (q + 1) : r * (q + 1) + (xcd - r) * q) + off; }
        const int nig = WGM * nN, gid = wgid / nig, fm = gid * WGM, gsz = (nM - fm) < WGM ? (nM - fm) : WGM;
        u.pm = fm + ((wgid % nig) % gsz); u.pn = (wgid % nig) / gsz; u.pz = 0; return true;
    }
    __device__ __forceinline__ void a_ready(const Unit&) const {}
    __device__ __forceinline__ void done(const Unit&) const {}
};
struct F8BalOrder {
    StaticOrder so; int c;
    __device__ __forceinline__ bool next(int i, Unit& u) const {
        if (so.G != 256 || so.nwg != 3456) return so.next(i, u);
        long L; if (i < 12) L = (long)i * 256 + c; else if (c >= 64 && i < 14) L = 3072 + (long)(i - 12) * 192 + (c - 64); else return false;
        StaticOrder t = so; t.G = 1; t.c = 0; return t.next((int)L, u);
    }
    __device__ __forceinline__ void a_ready(const Unit&) const {}
    __device__ __forceinline__ void done(const Unit&) const {}
};
template <int NZ> struct BatchOrder {
    StaticOrder so;
    __device__ __forceinline__ bool next(int i, Unit& u) const { if (!so.next(i / NZ, u)) return false; u.pz = i % NZ; return true; }
    __device__ __forceinline__ void a_ready(const Unit&) const {}
    __device__ __forceinline__ void done(const Unit&) const {}
};

typedef __bf16 bf16x2_t __attribute__((ext_vector_type(2)));
__device__ __forceinline__ unsigned cvt_pk_bf16(float lo, float hi) { const f32x2 v = {lo, hi}; return __builtin_bit_cast(unsigned, __builtin_convertvector(v, bf16x2_t)); }

typedef int v8i_t __attribute__((ext_vector_type(8)));
__device__ __forceinline__ v8i_t cat8(bf16x8 lo, bf16x8 hi) { const u32x4 a = __builtin_bit_cast(u32x4, lo), b = __builtin_bit_cast(u32x4, hi); return (v8i_t){(int)a.x, (int)a.y, (int)a.z, (int)a.w, (int)b.x, (int)b.y, (int)b.z, (int)b.w}; }
template <class Epi, class Sched, bool ALIGN_EPI = false, bool SP2 = false, bool F8 = false>
__device__ __forceinline__ void gemm_phase(PG8_LAS unsigned char* lds, const Gemm g, const Sched& S, const Epi& E) {
    int tid_ = threadIdx.x; asm volatile("" : "+v"(tid_));
    const int tid = tid_, wid = __builtin_amdgcn_readfirstlane(tid >> 6), lane = tid & 63, wr = wid >> 2, wc = wid & 3, fr = lane & 15, fq = lane >> 4;
    constexpr int EB = F8 ? 1 : 2;
    const int K = g.K, nt = K * EB / (BK * 2);
    unsigned voffA[2], voffB[2];
#pragma unroll
    for (int i = 0; i < 2; ++i) { int R, C; stage_rc(tid * 16 + i * 8192, R, C); const int Rb = Epi::PERM ? ((R & ~31) + perm32(R & 31)) : R;
        voffA[i] = (unsigned)(R * K * EB + C * 2); voffB[i] = (unsigned)(Rb * K * EB + C * 2); }
    const size_t kstep = (size_t)(BK * 2);
    const size_t hstep = (size_t)HALF * K * EB;
    const size_t tstep = 2 * hstep;
    const unsigned ldsw = (unsigned)wid * 1024u;
    const int aoff = lds_byte(wr * 64 + fr, fq * 8), boff = lds_byte(wc * 32 + fr, fq * 8);
#define PG8_SA(b, h) (((b) * 2 + (h)) * HTB)
#define PG8_SB(b, h) ((4 + (b) * 2 + (h)) * HTB)
#define PG8_STAGE(bufoff, gbase, voff) do { _Pragma("unroll") for (int _i = 0; _i < 2; ++_i) \
        __builtin_amdgcn_global_load_lds((const unsigned*)((const char*)(gbase) + (voff)[_i]), (PG8_LAS unsigned*)(lds + (bufoff) + ldsw + _i * 8192), 16, 0, 0); } while (0)
#define PG8_LDA(dst, b, h) do { if constexpr (F8) { _Pragma("unroll") for (int m = 0; m < 4; ++m) { const u32x4 _lo = *(const PG8_LAS u32x4*)(lds + PG8_SA(b, h) + aoff + m * 2048), _hi = *(const PG8_LAS u32x4*)(lds + PG8_SA(b, h) + aoff + m * 2048 + 1024); \
            dst##8[m] = (v8i_t){(int)_lo.x, (int)_lo.y, (int)_lo.z, (int)_lo.w, (int)_hi.x, (int)_hi.y, (int)_hi.z, (int)_hi.w}; } } \
        else { _Pragma("unroll") for (int m = 0; m < 4; ++m) _Pragma("unroll") for (int k = 0; k < 2; ++k) dst[m][k] = *(const PG8_LAS bf16x8*)(lds + PG8_SA(b, h) + aoff + m * 2048 + k * 1024); } } while (0)
#define PG8_LDB(dst, b, h) do { if constexpr (F8) { _Pragma("unroll") for (int n = 0; n < 2; ++n) { const u32x4 _lo = *(const PG8_LAS u32x4*)(lds + PG8_SB(b, h) + boff + n * 2048), _hi = *(const PG8_LAS u32x4*)(lds + PG8_SB(b, h) + boff + n * 2048 + 1024); \
            dst##8[n] = (v8i_t){(int)_lo.x, (int)_lo.y, (int)_lo.z, (int)_lo.w, (int)_hi.x, (int)_hi.y, (int)_hi.z, (int)_hi.w}; } } \
        else { _Pragma("unroll") for (int n = 0; n < 2; ++n) _Pragma("unroll") for (int k = 0; k < 2; ++k) dst[n][k] = *(const PG8_LAS bf16x8*)(lds + PG8_SB(b, h) + boff + n * 2048 + k * 1024); } } while (0)
#define PG8_MMA(ai, bj, At, Bt) do { __builtin_amdgcn_s_setprio(1); \
        if constexpr (F8) { _Pragma("unroll") for (int m = 0; m < 4; ++m) _Pragma("unroll") for (int n = 0; n < 2; ++n) \
            asm volatile("s_nop 1\n\tv_mfma_scale_f32_16x16x128_f8f6f4 %0, %1, %2, %0, %3, %3 op_sel_hi:[0,0,0]" : "+v"(acc[ai][bj][m][n]) : "v"(Bt##8[n]), "v"(At##8[m]), "v"(mxs)); } \
        else { _Pragma("unroll") for (int m = 0; m < 4; ++m) _Pragma("unroll") for (int n = 0; n < 2; ++n) _Pragma("unroll") for (int k = 0; k < 2; ++k) \
            acc[ai][bj][m][n] = __builtin_amdgcn_mfma_f32_16x16x32_bf16(Bt[n][k], At[m][k], acc[ai][bj][m][n], 0, 0, 0); } \
        __builtin_amdgcn_s_setprio(0); } while (0)
#define PG8_WAIT_V(n) asm volatile("s_waitcnt vmcnt(" #n ")" ::: "memory")
#define PG8_WAIT_L(n) asm volatile("s_waitcnt lgkmcnt(" #n ")" ::: "memory")
#define PG8_BAR __builtin_amdgcn_s_barrier()
#define PG8_SCHED __builtin_amdgcn_sched_barrier(0)
    Unit cur, nxt; int ui = 0;
    if (!S.next(0, cur)) return;
    f32x4 acc[2][2][4][2];
#pragma unroll
    for (int a = 0; a < 2; ++a)
#pragma unroll
        for (int b = 0; b < 2; ++b)
#pragma unroll
            for (int m = 0; m < 4; ++m)
#pragma unroll
                for (int n = 0; n < 2; ++n) acc[a][b][m][n] = (f32x4){0.f, 0.f, 0.f, 0.f};
    const int mxs = 0x7f7f7f7f;
    bf16x8 At[4][2], B0[2][2], B1[2][2]; v8i_t At8[4], B08[2], B18[2];
    const char* cA = (const char*)g.A + (size_t)cur.pm * tstep + (size_t)cur.pz * g.zA; const char* cB = (const char*)g.Bt + (size_t)cur.pn * tstep + (size_t)cur.pz * g.zB;
    S.a_ready(cur);
    if constexpr (SP2) {
        PG8_STAGE(PG8_SB(0, 0), cB, voffB); PG8_STAGE(PG8_SB(0, 1), cB + hstep, voffB); PG8_STAGE(PG8_SA(0, 0), cA, voffA); PG8_STAGE(PG8_SA(0, 1), cA + hstep, voffA);
        if (wr == 1) PG8_BAR;
        PG8_WAIT_V(2); PG8_BAR;
        PG8_STAGE(PG8_SB(1, 0), cB + kstep, voffB); PG8_STAGE(PG8_SA(1, 0), cA + kstep, voffA); PG8_STAGE(PG8_SB(1, 1), cB + hstep + kstep, voffB);
        PG8_WAIT_V(6); PG8_BAR;
    } else {
        PG8_STAGE(PG8_SB(0, 0), cB, voffB); PG8_STAGE(PG8_SA(0, 0), cA, voffA); PG8_STAGE(PG8_SB(0, 1), cB + hstep, voffB); PG8_STAGE(PG8_SA(0, 1), cA + hstep, voffA);
        if (wr == 1) PG8_BAR;
        PG8_WAIT_V(4); PG8_BAR;
        PG8_STAGE(PG8_SB(1, 0), cB + kstep, voffB); PG8_STAGE(PG8_SA(1, 0), cA + kstep, voffA); PG8_STAGE(PG8_SB(1, 1), cB + hstep + kstep, voffB);
        PG8_WAIT_V(6); PG8_BAR;
    }
    for (;;) {
        const bool has_next = S.next(ui + 1, nxt);
        const char* nA = has_next ? (const char*)g.A + (size_t)nxt.pm * tstep + (size_t)nxt.pz * g.zA : cA; const char* nB = has_next ? (const char*)g.Bt + (size_t)nxt.pn * tstep + (size_t)nxt.pz * g.zB : cB;
        for (int t = 0; t < nt; t += 2) {
            const bool last = (t == nt - 2);
            const char* a1 = cA + (size_t)(t + 1) * kstep;
            const char* a2 = last ? nA : cA + (size_t)(t + 2) * kstep; const char* b2 = last ? nB : cB + (size_t)(t + 2) * kstep;
            const char* a3 = a2 + kstep; const char* b3 = b2 + kstep;
            if (last && has_next) S.a_ready(nxt);
            if constexpr (SP2) {
            PG8_LDB(B0, 0, 0); PG8_LDB(B1, 0, 1); PG8_SCHED; PG8_LDA(At, 0, 0); PG8_STAGE(PG8_SA(1, 1), a1 + hstep, voffA);
            PG8_WAIT_V(8); PG8_WAIT_L(0); PG8_BAR; PG8_MMA(0, 0, At, B0); PG8_MMA(0, 1, At, B1); PG8_BAR; PG8_SCHED;
            PG8_LDA(At, 0, 1); PG8_STAGE(PG8_SB(0, 0), b2, voffB); PG8_STAGE(PG8_SB(0, 1), b2 + hstep, voffB); PG8_STAGE(PG8_SA(0, 0), a2, voffA);
            PG8_WAIT_V(8); PG8_WAIT_L(0); PG8_BAR; PG8_MMA(1, 0, At, B0); PG8_MMA(1, 1, At, B1); PG8_BAR; PG8_SCHED;
            PG8_LDB(B0, 1, 0); PG8_LDB(B1, 1, 1); PG8_SCHED; PG8_LDA(At, 1, 0); PG8_STAGE(PG8_SA(0, 1), a2 + hstep, voffA);
            PG8_WAIT_V(8); PG8_WAIT_L(0); PG8_BAR; PG8_MMA(0, 0, At, B0); PG8_MMA(0, 1, At, B1); PG8_BAR; PG8_SCHED;
            PG8_LDA(At, 1, 1); PG8_STAGE(PG8_SB(1, 0), b3, voffB); PG8_STAGE(PG8_SB(1, 1), b3 + hstep, voffB); PG8_STAGE(PG8_SA(1, 0), a3, voffA);
            PG8_WAIT_V(8); PG8_WAIT_L(0); PG8_BAR; PG8_MMA(1, 0, At, B0); PG8_MMA(1, 1, At, B1); PG8_BAR; PG8_SCHED;
            } else {
            PG8_LDB(B0, 0, 0); PG8_SCHED; PG8_LDA(At, 0, 0); PG8_STAGE(PG8_SA(1, 1), a1 + hstep, voffA);
            PG8_WAIT_L(8); PG8_BAR; PG8_WAIT_L(0); PG8_MMA(0, 0, At, B0); PG8_BAR; PG8_SCHED;
            PG8_LDB(B1, 0, 1); PG8_STAGE(PG8_SB(0, 0), b2, voffB);
            PG8_BAR; PG8_WAIT_L(0); PG8_MMA(0, 1, At, B1); PG8_BAR;
            PG8_LDA(At, 0, 1); PG8_STAGE(PG8_SA(0, 0), a2, voffA);
            PG8_BAR; PG8_WAIT_L(0); PG8_MMA(1, 0, At, B0); PG8_BAR; PG8_SCHED;
            PG8_STAGE(PG8_SB(0, 1), b2 + hstep, voffB);
            PG8_WAIT_V(6); PG8_BAR; PG8_MMA(1, 1, At, B1); PG8_BAR;
            PG8_LDB(B0, 1, 0); PG8_SCHED; PG8_LDA(At, 1, 0); PG8_STAGE(PG8_SA(0, 1), a2 + hstep, voffA);
            PG8_WAIT_L(8); PG8_BAR; PG8_WAIT_L(0); PG8_MMA(0, 0, At, B0); PG8_BAR; PG8_SCHED;
            PG8_LDB(B1, 1, 1); PG8_STAGE(PG8_SB(1, 0), b3, voffB);
            PG8_BAR; PG8_WAIT_L(0); PG8_MMA(0, 1, At, B1); PG8_BAR;
            PG8_LDA(At, 1, 1); PG8_STAGE(PG8_SA(1, 0), a3, voffA);
            PG8_BAR; PG8_WAIT_L(0); PG8_MMA(1, 0, At, B0); PG8_BAR; PG8_SCHED;
            PG8_STAGE(PG8_SB(1, 1), b3 + hstep, voffB);
            PG8_WAIT_V(6); PG8_BAR; PG8_MMA(1, 1, At, B1); PG8_BAR;
            }
        }
        if constexpr (ALIGN_EPI) { if (wr == 0) PG8_BAR; }
        if constexpr (F8) { asm volatile("s_nop 15\n\ts_nop 15" ::: "memory");
#pragma unroll
            for (int a = 0; a < 2; ++a)
#pragma unroll
                for (int b = 0; b < 2; ++b)
#pragma unroll
                    for (int m = 0; m < 4; ++m)
#pragma unroll
                        for (int n = 0; n < 2; ++n) asm volatile("" : "+v"(acc[a][b][m][n])); }
        E(acc, cur, wr, wc, fr, fq); S.done(cur);
        if (!has_next) break;
        if (!Epi::CHAIN || nxt.pz == 0) {
#pragma unroll
        for (int a = 0; a < 2; ++a)
#pragma unroll
            for (int b = 0; b < 2; ++b)
#pragma unroll
                for (int m = 0; m < 4; ++m)
#pragma unroll
                    for (int n = 0; n < 2; ++n) acc[a][b][m][n] = (f32x4){0.f, 0.f, 0.f, 0.f};
        }
        cur = nxt; cA = nA; cB = nB; ++ui;
        if constexpr (ALIGN_EPI) { if (wr == 1) PG8_BAR; }
    }
    PG8_WAIT_V(0);
    if constexpr (!ALIGN_EPI) { if (wr == 0) PG8_BAR; }
    PG8_BAR;
#undef PG8_SA
#undef PG8_SB
#undef PG8_STAGE
#undef PG8_LDA
#undef PG8_LDB
#undef PG8_MMA
#undef PG8_WAIT_V
#undef PG8_WAIT_L
#undef PG8_BAR
#undef PG8_SCHED
}

__device__ __forceinline__ float sigm(float v) { return __builtin_amdgcn_rcpf(1.0f + __expf(-v)); }

struct EpiProj {
    static constexpr bool PERM = true; static constexpr bool CHAIN = false;
    bf16_t* O; const float* rope;
    __device__ __forceinline__ void operator()(const f32x4 (&acc)[2][2][4][2], const Unit& u, int wr, int wc, int fr, int fq) const {
        const int row0 = u.pm * BM + wr * 64 + fr, col0 = u.pn * BM + wc * 32 + 8 * fq;
        const int mode = (u.pn >= 27) ? 2 : ((u.pn >= 16 && u.pn < 20) ? 1 : 0);
        const int ip = 16 * wc + 4 * fq;
#pragma unroll
        for (int ai = 0; ai < 2; ++ai)
#pragma unroll
            for (int m = 0; m < 4; ++m) { const int row = row0 + ai * HALF + m * 16; bf16_t* rowp = O + (size_t)row * NPROJ + col0;
                f32x4 r0 = (f32x4){1.f, 0.f, 1.f, 0.f}, r1 = r0;
                if (mode == 1) { const f32x4* rp = (const f32x4*)(rope + ((size_t)(row & (SEQ - 1)) * 64 + ip) * 2); r0 = rp[0]; r1 = rp[1]; }
#pragma unroll
                for (int bj = 0; bj < 2; ++bj) { f32x4 v0 = acc[ai][bj][m][0], v1 = acc[ai][bj][m][1];
                    if (mode == 2) { v0 = (f32x4){sigm(v0[0]), sigm(v0[1]), sigm(v0[2]), sigm(v0[3])}; v1 = (f32x4){sigm(v1[0]), sigm(v1[1]), sigm(v1[2]), sigm(v1[3])}; }
                    else if (mode == 1) {
                        v0 = (f32x4){v0[0] * r0[0] - v0[1] * r0[1], v0[1] * r0[0] + v0[0] * r0[1], v0[2] * r0[2] - v0[3] * r0[3], v0[3] * r0[2] + v0[2] * r0[3]};
                        v1 = (f32x4){v1[0] * r1[0] - v1[1] * r1[1], v1[1] * r1[0] + v1[0] * r1[1], v1[2] * r1[2] - v1[3] * r1[3], v1[3] * r1[2] + v1[2] * r1[3]}; }
                    u32x4 w; w.x = cvt_pk_bf16(v0[0], v0[1]); w.y = cvt_pk_bf16(v0[2], v0[3]); w.z = cvt_pk_bf16(v1[0], v1[1]); w.w = cvt_pk_bf16(v1[2], v1[3]);
                    *(u32x4*)(rowp + bj * HALF) = w; } }
    }
};
struct EpiF8 {
    static constexpr bool PERM = true; static constexpr bool CHAIN = false;
    bf16_t* O; const float* rs; const float* cs; const float* rope;
    __device__ __forceinline__ void operator()(const f32x4 (&acc)[2][2][4][2], const Unit& u, int wr, int wc, int fr, int fq) const {
        const int row0 = u.pm * BM + wr * 64 + fr, col8 = u.pn * BM + wc * 32 + 8 * fq;
        const int colp = u.pn * BM + wc * 32 + 8 * fq;
        const int mode = (u.pn >= 22) ? 2 : ((u.pn >= 16 && u.pn < 20) ? 1 : 0);
        const int ip = 16 * wc + 4 * fq;
        float rr[2][4]; f32x4 cc[2][2];
#pragma unroll
        for (int ai = 0; ai < 2; ++ai)
#pragma unroll
            for (int m = 0; m < 4; ++m) rr[ai][m] = rs[row0 + ai * HALF + m * 16];
#pragma unroll
        for (int bj = 0; bj < 2; ++bj) { cc[bj][0] = *(const f32x4*)(cs + col8 + bj * HALF); cc[bj][1] = *(const f32x4*)(cs + col8 + bj * HALF + 4); }
        if (mode == 2) {
            const int chan = OFF_GATE + (u.pn - 22) * 64 + wc * 16 + 4 * fq;
#pragma unroll
            for (int ai = 0; ai < 2; ++ai)
#pragma unroll
                for (int m = 0; m < 4; ++m) { const int row = row0 + ai * HALF + m * 16; const float r = rr[ai][m]; bf16_t* rowp = O + (size_t)row * NPROJ + chan;
                    f32x4 e[4], gi[4];
#pragma unroll
                    for (int b = 0; b < 4; ++b) { const f32x4 v = acc[ai][b >> 1][m][b & 1] * cc[b >> 1][b & 1] * r;
#pragma unroll
                        for (int q = 0; q < 4; ++q) { e[b][q] = 1.0f + __expf(-fminf(fmaxf(v[q], -30.0f), 30.0f)); gi[b][q] = __builtin_amdgcn_rcpf(e[b][q]); } }
#pragma unroll
                    for (int k = 0; k < 4; ++k) { const f32x4 o = (k < 3) ? gi[k] * e[(k + 1) & 3] : gi[3];
                        u32x2 w; w.x = cvt_pk_bf16(o[0], o[1]); w.y = cvt_pk_bf16(o[2], o[3]); *(u32x2*)(rowp + k * D) = w; } }
            return;
        }
#pragma unroll
        for (int ai = 0; ai < 2; ++ai)
#pragma unroll
            for (int m = 0; m < 4; ++m) { const int row = row0 + ai * HALF + m * 16; const float r = rr[ai][m]; bf16_t* rowp = O + (size_t)row * NPROJ + colp;
                f32x4 r0 = (f32x4){1.f, 0.f, 1.f, 0.f}, r1 = r0;
                if (mode == 1) { const f32x4* rp = (const f32x4*)(rope + ((size_t)(row & (SEQ - 1)) * 64 + ip) * 2); r0 = rp[0]; r1 = rp[1]; }
#pragma unroll
                for (int bj = 0; bj < 2; ++bj) { const f32x4 c0 = cc[bj][0], c1 = cc[bj][1];
                    f32x4 v0 = acc[ai][bj][m][0] * c0 * r, v1 = acc[ai][bj][m][1] * c1 * r;
                    if (mode == 1) {
                        v0 = (f32x4){v0[0] * r0[0] - v0[1] * r0[1], v0[1] * r0[0] + v0[0] * r0[1], v0[2] * r0[2] - v0[3] * r0[3], v0[3] * r0[2] + v0[2] * r0[3]};
                        v1 = (f32x4){v1[0] * r1[0] - v1[1] * r1[1], v1[1] * r1[0] + v1[0] * r1[1], v1[2] * r1[2] - v1[3] * r1[3], v1[3] * r1[2] + v1[2] * r1[3]}; }
                    u32x4 w; w.x = cvt_pk_bf16(v0[0], v0[1]); w.y = cvt_pk_bf16(v0[2], v0[3]); w.z = cvt_pk_bf16(v1[0], v1[1]); w.w = cvt_pk_bf16(v1[2], v1[3]);
                    *(u32x4*)(rowp + bj * HALF) = w; } }
    }
};
struct EpiBf16 {
    static constexpr bool PERM = true; static constexpr bool CHAIN = false;
    bf16_t* O; int ldc;
    __device__ __forceinline__ void operator()(const f32x4 (&acc)[2][2][4][2], const Unit& u, int wr, int wc, int fr, int fq) const {
        const int row0 = u.pm * BM + wr * 64 + fr, col0 = u.pn * BM + wc * 32 + 8 * fq;
#pragma unroll
        for (int ai = 0; ai < 2; ++ai)
#pragma unroll
            for (int m = 0; m < 4; ++m) { bf16_t* rowp = O + (size_t)(row0 + ai * HALF + m * 16) * ldc + col0;
#pragma unroll
                for (int bj = 0; bj < 2; ++bj) { const f32x4 v0 = acc[ai][bj][m][0], v1 = acc[ai][bj][m][1];
                    u32x4 w; w.x = cvt_pk_bf16(v0[0], v0[1]); w.y = cvt_pk_bf16(v0[2], v0[3]); w.z = cvt_pk_bf16(v1[0], v1[1]); w.w = cvt_pk_bf16(v1[2], v1[3]);
                    *(u32x4*)(rowp + bj * HALF) = w; } }
    }
};
struct EpiBranch {
    static constexpr bool PERM = true; static constexpr bool CHAIN = true;
    bf16_t* Y; const bf16_t* proj;
    __device__ __forceinline__ void operator()(f32x4 (&acc)[2][2][4][2], const Unit& u, int wr, int wc, int fr, int fq) const {
        const int row0 = u.pm * BM + wr * 64 + fr, col0 = u.pn * BM + wc * 32 + 8 * fq;
        u32x4 gw[2][4][2];
#pragma unroll
        for (int ai = 0; ai < 2; ++ai)
#pragma unroll
            for (int m = 0; m < 4; ++m)
#pragma unroll
                for (int bj = 0; bj < 2; ++bj) gw[ai][m][bj] = *(const u32x4*)(proj + (size_t)(row0 + ai * HALF + m * 16) * NPROJ + OFF_GATE + u.pz * D + col0 + bj * HALF);
#pragma unroll
        for (int ai = 0; ai < 2; ++ai)
#pragma unroll
            for (int m = 0; m < 4; ++m)
#pragma unroll
                for (int bj = 0; bj < 2; ++bj) { const u32x4 g = gw[ai][m][bj];
                    acc[ai][bj][m][0] = acc[ai][bj][m][0] * (f32x4){bflo(g.x), bfhi(g.x), bflo(g.y), bfhi(g.y)};
                    acc[ai][bj][m][1] = acc[ai][bj][m][1] * (f32x4){bflo(g.z), bfhi(g.z), bflo(g.w), bfhi(g.w)}; }
        if (u.pz == 3) {
#pragma unroll
            for (int ai = 0; ai < 2; ++ai)
#pragma unroll
                for (int m = 0; m < 4; ++m) { bf16_t* yp = Y + (size_t)(row0 + ai * HALF + m * 16) * D + col0;
#pragma unroll
                    for (int bj = 0; bj < 2; ++bj) { const f32x4 v0 = acc[ai][bj][m][0], v1 = acc[ai][bj][m][1];
                        u32x4 w; w.x = cvt_pk_bf16(v0[0], v0[1]); w.y = cvt_pk_bf16(v0[2], v0[3]); w.z = cvt_pk_bf16(v1[0], v1[1]); w.w = cvt_pk_bf16(v1[2], v1[3]);
                        *(u32x4*)(yp + bj * HALF) = w; } }
        }
    }
};
struct EpiResid {
    static constexpr bool PERM = false; static constexpr bool CHAIN = false;
    const float* xin; float* xout; const float* gate;
    __device__ __forceinline__ void operator()(const f32x4 (&acc)[2][2][4][2], const Unit& u, int wr, int wc, int fr, int fq) const {
        const int row0 = u.pm * BM + wr * 64 + fr, col0 = u.pn * BM + wc * 32 + 4 * fq;
        const float* gb = gate + (size_t)((u.pm * BM) >> 11) * 12288 + col0;
        f32x4 gv[2][2];
#pragma unroll
        for (int bj = 0; bj < 2; ++bj)
#pragma unroll
            for (int n = 0; n < 2; ++n) gv[bj][n] = *(const f32x4*)(gb + bj * HALF + n * 16);
#pragma unroll
        for (int ai = 0; ai < 2; ++ai) {
            f32x4 xi[4][2][2];
#pragma unroll
            for (int m = 0; m < 4; ++m)
#pragma unroll
                for (int bj = 0; bj < 2; ++bj)
#pragma unroll
                    for (int n = 0; n < 2; ++n) xi[m][bj][n] = *(const f32x4*)(xin + (size_t)(row0 + ai * HALF + m * 16) * D + col0 + bj * HALF + n * 16);
#pragma unroll
            for (int m = 0; m < 4; ++m)
#pragma unroll
                for (int bj = 0; bj < 2; ++bj)
#pragma unroll
                    for (int n = 0; n < 2; ++n) *(f32x4*)(xout + (size_t)(row0 + ai * HALF + m * 16) * D + col0 + bj * HALF + n * 16) = xi[m][bj][n] + gv[bj][n] * acc[ai][bj][m][n];
        }
    }
};
}

#define XB_TMO      128
#define XB_XCNT(j)  (256  + 64 * (j))
#define XB_XSUB(j)  (1280 + 64 * (j))
#define XB_XGEN(j)  (2304 + 64 * (j))
#define XB_TOP      3328
#define XB_TOPGEN   3392
#define XCD_BAR_WORDS 3456
#define XB_SPIN_CAP (1u << 18)
__device__ __forceinline__ unsigned xb_ld(unsigned* p)              { return __hip_atomic_load(p, __ATOMIC_RELAXED, __HIP_MEMORY_SCOPE_AGENT); }
__device__ __forceinline__ unsigned xb_add(unsigned* p, unsigned v) { return __hip_atomic_fetch_add(p, v, __ATOMIC_RELAXED, __HIP_MEMORY_SCOPE_AGENT); }
__device__ __forceinline__ unsigned xb_xcc_id() { return (unsigned)__builtin_amdgcn_s_getreg((3 << 11) | 20) & 0xFu; }
#define XB_SPIN(cond, bar) do { unsigned _sp = 0; while (cond) { __builtin_amdgcn_s_sleep(1); \
    if ((++_sp & 255u) == 0u) { if (xb_ld(&(bar)[XB_TMO])) break; if (_sp > XB_SPIN_CAP) { atomicAdd(&(bar)[XB_TMO], 1u); break; } } } } while (0)
struct XcdBarrier { unsigned* bar; unsigned x; volatile LAS unsigned* st; };
__device__ __forceinline__ XcdBarrier xcd_barrier_post(unsigned* bar, volatile LAS unsigned* st) {
    XcdBarrier b; b.bar = bar; b.x = xb_xcc_id(); b.st = st;
    if (threadIdx.x == 0) (void)xb_add(&bar[XB_XCNT(b.x)], 1u);
    return b;
}
__device__ __forceinline__ void xcd_barrier_complete(unsigned* bar, unsigned x, unsigned& nloc, unsigned& nx) {
    const unsigned G = gridDim.x * gridDim.y * gridDim.z;
    unsigned sum, cnt, mine, sp = 0u;
    for (;;) {
        sum = 0u; cnt = 0u; mine = 0u;
#pragma unroll
        for (unsigned j = 0; j < 16; ++j) { const unsigned c = xb_ld(&bar[XB_XCNT(j)]); sum += c; cnt += (c > 0u) ? 1u : 0u; mine = (j == x) ? c : mine; }
        if (sum == G) break;
        __builtin_amdgcn_s_sleep(1);
        if ((++sp & 255u) == 0u) { if (xb_ld(&bar[XB_TMO])) break; if (sp > XB_SPIN_CAP) { atomicAdd(&bar[XB_TMO], 1u); break; } }
    }
    nloc = mine > 0u ? mine : 1u; nx = cnt > 0u ? cnt : 1u;
}
__device__ __forceinline__ void xcd_barrier(const XcdBarrier& b) {
    asm volatile("s_waitcnt vmcnt(0)" ::: "memory");
    __syncthreads();
    if (threadIdx.x == 0) {
        unsigned* bar = b.bar; asm volatile("" : "+s"(bar));
        __builtin_amdgcn_s_waitcnt(0);
        unsigned nloc = b.st[0], nx = b.st[1];
        if (nloc == 0u) { xcd_barrier_complete(bar, b.x, nloc, nx); b.st[0] = nloc; b.st[1] = nx; }
        const unsigned old = xb_add(&bar[XB_XSUB(b.x)], 1u);
        const unsigned gen = old / nloc;
        if (old + 1u == (gen + 1u) * nloc) {
            __builtin_amdgcn_fence(__ATOMIC_RELEASE, "agent");
            asm volatile("s_waitcnt vmcnt(0)" ::: "memory");
            const unsigned og = xb_add(&bar[XB_TOP], 1u);
            const unsigned tg = og / nx;
            if (og + 1u == (tg + 1u) * nx) xb_add(&bar[XB_TOPGEN], 1u);
            else XB_SPIN(xb_ld(&bar[XB_TOPGEN]) == tg, bar);
            __builtin_amdgcn_fence(__ATOMIC_ACQUIRE, "agent");
            xb_add(&bar[XB_XGEN(b.x)], 1u);
            asm volatile("s_waitcnt vmcnt(0)" ::: "memory");
        } else {
            XB_SPIN(xb_ld(&bar[XB_XGEN(b.x)]) == gen, bar);
            __builtin_amdgcn_fence(__ATOMIC_ACQUIRE, "agent");
            asm volatile("s_waitcnt vmcnt(0)" ::: "memory");
        }
    }
    __syncthreads();
}

struct P {
    const float *x, *c, *ada_w, *ada_b, *norm1_g, *norm2_g, *w_in, *conv_w, *sg_norm_g, *sg_w, *sg_b, *rel_bias, *w_branch, *w_o, *peer_wq, *peer_keys, *peer_u, *peer_v, *final_g;
    float* out; unsigned char* ws; int ph_lo, ph_hi;
};
struct Ctx { int tid, lane, wave, G, gtid, NT, gw, NGW; LAS unsigned char* lds; };
typedef const __attribute__((address_space(4))) P* KP;
__device__ __forceinline__ KP kargs() { KP q = (KP)__builtin_amdgcn_kernarg_segment_ptr(); asm volatile("" : "+s"(q)); return q; }
__device__ __forceinline__ Ctx make_ctx() {
    extern __shared__ __attribute__((aligned(16))) unsigned char lds_raw[];
    Ctx c; c.lds = (LAS unsigned char*)lds_raw;
    int tid = threadIdx.x; asm volatile("" : "+v"(tid));
    c.tid = tid; c.lane = tid & 63; c.wave = __builtin_amdgcn_readfirstlane(tid >> 6);
    c.G = gridDim.x; c.gtid = blockIdx.x * NTHR + tid; c.NT = c.G * NTHR; c.gw = blockIdx.x * NWAVES + c.wave; c.NGW = c.G * NWAVES;
    return c;
}

__device__ __forceinline__ void transpose_item(const float* W, int ldw, int K, int mode, bf16* WT, LAS float* scr, int item, int nblk, int lane) {
    const int kb = item / nblk, nb = item % nblk, k0 = 64 * kb, n0 = 32 * nb;
    int sc = n0 + (lane & 31); if (mode == 1) sc = win_src_col(sc); else if (mode == 2) sc = win_src_col(BF_LO + sc);
    float v[32]; const int scc = sc >= 0 ? sc : 0;
#pragma unroll
    for (int i = 0; i < 32; ++i) { const int kk = 2 * i + (lane >> 5); v[i] = W[(size_t)(k0 + kk) * ldw + scc]; }
    asm volatile("" ::: "memory");
#pragma unroll
    for (int i = 0; i < 32; ++i) { const int kk = 2 * i + (lane >> 5); scr[kk * 33 + (lane & 31)] = sc >= 0 ? v[i] : 0.f; }
    LDS_WAIT(); asm volatile("" ::: "memory");
    const int c = lane & 7;
#pragma unroll
    for (int j = 0; j < 4; ++j) { const int n = (lane >> 3) + 8 * j; const LAS float* s = scr + (8 * c) * 33 + n;
        u32x4 o; o.x = pk2(s[0 * 33], s[1 * 33]); o.y = pk2(s[2 * 33], s[3 * 33]); o.z = pk2(s[4 * 33], s[5 * 33]); o.w = pk2(s[6 * 33], s[7 * 33]);
        *(u32x4*)(WT + (size_t)(n0 + n) * K + k0 + 8 * c) = o; }
    LDS_WAIT(); asm volatile("" ::: "memory");
}
__device__ __forceinline__ void cvt_rows(const float* src, bf16* dst, size_t n8, int gtid, int NT) {
    for (size_t i = gtid; i < n8; i += NT) { const f32x4 a = ((const f32x4*)src)[2 * i], b = ((const f32x4*)src)[2 * i + 1];
        u32x4 o; o.x = pk2(a[0], a[1]); o.y = pk2(a[2], a[3]); o.z = pk2(b[0], b[1]); o.w = pk2(b[2], b[3]); ((u32x4*)dst)[i] = o; }
}
__device__ __forceinline__ void phase_prep(KP p, int l) { const Ctx c = make_ctx();
    unsigned char* ws = p->ws;
    LAS float* scr = (LAS float*)(c.lds + c.wave * 16384);
    constexpr int I_IN = (D / 64) * (NPROJ_BF / 32), I_B = (BRW / 64) * (D / 32), I_O = (D / 64) * (D / 32);
    constexpr int NITEMS = I_IN + 4 * I_B + 2 * I_O;
    for (int it = c.gw; it < NITEMS; it += c.NGW) {
        int r = it;
        if (r < I_IN) { transpose_item(p->w_in + (size_t)l * D * PIN, PIN, D, 2, (bf16*)(ws + WS_WIN), scr, r, NPROJ_BF / 32, c.lane); continue; } r -= I_IN;
        if (r < 4 * I_B) { const int i = r / I_B; transpose_item(p->w_branch + ((size_t)l * 4 + i) * BRW * D, D, BRW, 0, (bf16*)(ws + WS_WB) + (size_t)i * D * BRW, scr, r % I_B, D / 32, c.lane); continue; } r -= 4 * I_B;
        if (r < I_O) { transpose_item(p->w_o + (size_t)l * D * D, D, D, 0, (bf16*)(ws + WS_WO), scr, r, D / 32, c.lane); continue; } r -= I_O;
        transpose_item(p->peer_wq + (size_t)l * D * D, D, D, 0, (bf16*)(ws + WS_WQ), scr, r, D / 32, c.lane);
    }
    {
        float* scl = (float*)(ws + WS_SCL);
        const int step = 2 * c.NGW;
#define PT_LOAD(V, R0) do { _Pragma("unroll") for (int h = 0; h < 2; ++h) { const int row = (R0) + h, r = row & 16383; \
            const f32x4* src = (const f32x4*)(((row < 16384) ? p->peer_u : p->peer_v) + ((size_t)l * 16384 + r) * D) + c.lane; \
            _Pragma("unroll") for (int q = 0; q < 8; ++q) V[h][q] = src[64 * q]; } } while (0)
#define PT_DO(V, R0) do { float am[2]; \
            _Pragma("unroll") for (int h = 0; h < 2; ++h) { float a = 0.f; \
                _Pragma("unroll") for (int q = 0; q < 8; ++q) a = fmaxf(a, fmaxf(fmaxf(fabsf(V[h][q][0]), fabsf(V[h][q][1])), fmaxf(fabsf(V[h][q][2]), fabsf(V[h][q][3])))); \
                am[h] = wave_amax(a); } \
            _Pragma("unroll") for (int h = 0; h < 2; ++h) { const int row = (R0) + h, r = row & 16383; const float sc = am[h] > 0.f ? 240.0f / am[h] : 1.0f; \
                const bool isv = row >= 16384;     \
                _Pragma("unroll") for (int q = 0; q < 8; ++q) { int w = 0; w = __builtin_amdgcn_cvt_pk_fp8_f32(V[h][q][0] * sc, V[h][q][1] * sc, w, false); w = __builtin_amdgcn_cvt_pk_fp8_f32(V[h][q][2] * sc, V[h][q][3] * sc, w, true); \
                    const int wi = c.lane + 64 * q;     \
                    unsigned* dst = (unsigned*)(ws + (isv ? WS_V : WS_U) + ((size_t)(wi >> 5) * 16384 + r) * 128) + (wi & 31);     \
                    *dst = (unsigned)w; } \
                if (c.lane == 0) scl[row] = am[h] > 0.f ? am[h] * (1.0f / 240.0f) : 1.0f; } } while (0)
        int row0 = 2 * c.gw;
        if (row0 < 32768) {
            f32x4 va[2][8], vb[2][8];
            PT_LOAD(va, row0);
            for (; row0 + 2 * step < 32768; row0 += 2 * step) {
                PT_LOAD(vb, row0 + step); PT_DO(va, row0);
                PT_LOAD(va, row0 + 2 * step); PT_DO(vb, row0 + step);
            }
            if (row0 + step < 32768) { PT_LOAD(vb, row0 + step); PT_DO(va, row0); PT_DO(vb, row0 + step); }
            else PT_DO(va, row0);
        }
#undef PT_LOAD
#undef PT_DO
    }
    cvt_rows(p->peer_keys + (size_t)l * 262144, (bf16*)(ws + WS_KEYS), (size_t)262144 / 8, c.gtid, c.NT);
    if (l == 0) {
        float* rope = (float*)(ws + WS_ROPE);
        for (int e = c.gtid; e < SEQ * 64; e += c.NT) { const int pos = e >> 6, i = e & 63;
            const float inv = exp2f(-(float)i * (13.287712379549449f / 64.0f));
            const float ang = (float)pos * inv;
            const double rev = (double)ang * 0.15915494309189535; const float fr = (float)(rev - rint(rev));
            rope[2 * e] = __builtin_amdgcn_cosf(fr); rope[2 * e + 1] = __builtin_amdgcn_sinf(fr); }
        __syncthreads();
        LAS float* cact = (LAS float*)c.lds; LAS float* red = (LAS float*)(c.lds + 65536);
        float* mod = (float*)(ws + WS_MOD);
        bool loaded = false;
        for (int u = blockIdx.x; u < 256; u += c.G) {
            if (!loaded) { for (int i = c.tid; i < NBATCH * D; i += NTHR) { const float v = p->c[i]; cact[i] = v / (1.0f + __expf(-v)); } loaded = true; }
            __syncthreads();
            const int layer = u >> 7, col0 = (u & 127) * 96, kk = c.tid >> 5, jj = c.tid & 31;
            float acc[NBATCH][3];
#pragma unroll
            for (int b = 0; b < NBATCH; ++b) { acc[b][0] = 0.f; acc[b][1] = 0.f; acc[b][2] = 0.f; }
            const float* wbase = p->ada_w + (size_t)layer * D * 12288 + col0 + jj;
            for (int i0 = 0; i0 < 128; i0 += 8) {
                float w[8][3];
#pragma unroll
                for (int u = 0; u < 8; ++u) { const float* wr = wbase + (size_t)(kk + 16 * (i0 + u)) * 12288; w[u][0] = wr[0]; w[u][1] = wr[32]; w[u][2] = wr[64]; }
#pragma unroll
                for (int u = 0; u < 8; ++u) { const int k = kk + 16 * (i0 + u);
#pragma unroll
                    for (int b = 0; b < NBATCH; ++b) { const float cb = cact[b * D + k]; acc[b][0] += cb * w[u][0]; acc[b][1] += cb * w[u][1]; acc[b][2] += cb * w[u][2]; } } }
#pragma unroll
            for (int b = 0; b < NBATCH; ++b) { red[kk * 768 + b * 96 + jj] = acc[b][0]; red[kk * 768 + b * 96 + 32 + jj] = acc[b][1]; red[kk * 768 + b * 96 + 64 + jj] = acc[b][2]; }
            __syncthreads();
            for (int o = c.tid; o < 768; o += NTHR) { float s = 0.f;
#pragma unroll
                for (int q = 0; q < 16; ++q) s += red[q * 768 + o];
                const int b = o / 96, cc = o % 96; mod[((size_t)layer * NBATCH + b) * 12288 + col0 + cc] = s + p->ada_b[(size_t)layer * 12288 + col0 + cc]; }
            __syncthreads();
        }
    }
}


__device__ __forceinline__ void gate_col_amax(KP p) {
    const Ctx c = make_ctx();
    int* cs = (int*)(p->ws + WS_CS); LAS float* red = (LAS float*)c.lds;
    constexpr int NCB = (PIN + 255) / 256;
    for (int u = blockIdx.x; u < 2 * NCB * 4; u += c.G) { const int layer = u / (NCB * 4), cb = (u / 4) % NCB, kq = u & 3; const int c4 = cb * 256 + 4 * c.lane; const bool ok = c4 < PIN;
        const float* w = p->w_in + (size_t)layer * D * PIN + (ok ? c4 : 0) + (size_t)(kq * 512 + c.wave * 64) * PIN;
        f32x4 am = (f32x4){0.f, 0.f, 0.f, 0.f};
#pragma unroll 16
        for (int i = 0; i < 64; ++i) { const f32x4 v = *(const f32x4*)(w + (size_t)i * PIN); am = (f32x4){fmaxf(am[0], fabsf(v[0])), fmaxf(am[1], fabsf(v[1])), fmaxf(am[2], fabsf(v[2])), fmaxf(am[3], fabsf(v[3]))}; }
        __syncthreads(); *(LAS f32x4*)(red + c.wave * 256 + 4 * c.lane) = am; __syncthreads();
        if (c.tid < 256 && cb * 256 + c.tid < PIN) { float a = red[c.tid];
#pragma unroll
            for (int q = 1; q < 8; ++q) a = fmaxf(a, red[c.tid + 256 * q]);
            atomicMax(cs + layer * PIN + cb * 256 + c.tid, __float_as_int(a)); }
    }
    __syncthreads();
}
__device__ __forceinline__ void gate_transpose_f8(KP p, int l) {
    const Ctx c = make_ctx();
    LAS float* scr = (LAS float*)(c.lds + c.wave * 16384); const float* cs = (const float*)(p->ws + WS_CS) + l * PIN; float* csd = (float*)(p->ws + WS_CSD); unsigned char* WT = p->ws + WS_WG8;
    const float* W = p->w_in + (size_t)l * D * PIN;
    constexpr int NBLK = N8 / 32, NITEM = (D / 64) * NBLK;
    for (int it = c.gw; it < NITEM; it += c.NGW) { const int kb = it / NBLK, nb = it % NBLK, k0 = 64 * kb, n0 = 32 * nb; const int sc0 = f8_src_col(n0 + (c.lane & 31));
        float v[32];
#pragma unroll
        for (int i = 0; i < 32; ++i) { const int kk = 2 * i + (c.lane >> 5); v[i] = W[(size_t)(k0 + kk) * PIN + sc0]; }
        asm volatile("" ::: "memory");
#pragma unroll
        for (int i = 0; i < 32; ++i) { const int kk = 2 * i + (c.lane >> 5); scr[kk * 33 + (c.lane & 31)] = v[i]; }
        LDS_WAIT(); asm volatile("" ::: "memory");
        const int ch = c.lane & 3;
#pragma unroll
        for (int j = 0; j < 2; ++j) { const int n = (c.lane >> 2) + 16 * j; const float cam = cs[f8_src_col(n0 + n)]; const float sc = cam > 0.f ? 240.0f / cam : 1.0f; const LAS float* sp = scr + (16 * ch) * 33 + n;
            if (kb == 0 && ch == 0) csd[n0 + n] = cam > 0.f ? cam * (1.0f / 240.0f) : 1.0f;
            u32x4 o; unsigned wv[4];
#pragma unroll
            for (int q = 0; q < 4; ++q) { int w = 0; w = __builtin_amdgcn_cvt_pk_fp8_f32(sp[(4 * q) * 33] * sc, sp[(4 * q + 1) * 33] * sc, w, false); w = __builtin_amdgcn_cvt_pk_fp8_f32(sp[(4 * q + 2) * 33] * sc, sp[(4 * q + 3) * 33] * sc, w, true); wv[q] = (unsigned)w; }
            o.x = wv[0]; o.y = wv[1]; o.z = wv[2]; o.w = wv[3];
            *(u32x4*)(WT + (size_t)(n0 + n) * D + k0 + 16 * ch) = o; }
        LDS_WAIT(); asm volatile("" ::: "memory");
    }
}

template <bool F8OUT>
__device__ __forceinline__ void phase_norm_mod(const float* xin, const float* g, const float* sh, const float* sc, bf16* out, unsigned char* out8, float* rs) {
    const Ctx c = make_ctx();
    for (int t = c.gw; t < T; t += c.NGW) {
        const f32x4* xr = (const f32x4*)(xin + (size_t)t * D) + c.lane;
        f32x4 v[8]; float ss = 0.f;
#pragma unroll
        for (int j = 0; j < 8; ++j) { v[j] = xr[64 * j]; ss += (v[j][0] * v[j][0] + v[j][1] * v[j][1]) + (v[j][2] * v[j][2] + v[j][3] * v[j][3]); }
        const float rstd = 1.0f / sqrtf(wave_sum(ss) * (1.0f / D) + EPS);
        const int b = t >> 11;
        const f32x4* gp = (const f32x4*)g + c.lane; const f32x4* shp = (const f32x4*)(sh + (size_t)b * 12288) + c.lane; const f32x4* scp = (const f32x4*)(sc + (size_t)b * 12288) + c.lane;
        u32x2* o8 = (u32x2*)(out + (size_t)t * D) + c.lane; float am = 0.f;
        f32x4 ggv[8], s1v[8], s0v[8];
#pragma unroll
        for (int j = 0; j < 8; ++j) { ggv[j] = gp[64 * j]; s1v[j] = scp[64 * j]; s0v[j] = shp[64 * j]; }
#pragma unroll
        for (int j = 0; j < 8; ++j) { const f32x4 gg = ggv[j], s1 = s1v[j], s0 = s0v[j];
            const f32x4 y = v[j] * rstd * gg * (s1 + 1.0f) + s0; v[j] = y;
            u32x2 w; w.x = pk2(y[0], y[1]); w.y = pk2(y[2], y[3]); o8[64 * j] = w;
            if (F8OUT) am = fmaxf(am, fmaxf(fmaxf(fabsf(y[0]), fabsf(y[1])), fmaxf(fabsf(y[2]), fabsf(y[3])))); }
        if (F8OUT) { am = wave_amax(am); const float q = am > 0.f ? 240.0f / am : 1.0f; unsigned* o1 = (unsigned*)(out8 + (size_t)t * D) + c.lane;
#pragma unroll
            for (int j = 0; j < 8; ++j) { int w = 0; w = __builtin_amdgcn_cvt_pk_fp8_f32(v[j][0] * q, v[j][1] * q, w, false); w = __builtin_amdgcn_cvt_pk_fp8_f32(v[j][2] * q, v[j][3] * q, w, true); o1[64 * j] = (unsigned)w; }
            if (c.lane == 0) rs[t] = am > 0.f ? am * (1.0f / 240.0f) : 1.0f; }
    }
}
__device__ __forceinline__ void phase_final_norm(const float* xin, const float* g, float* out) {
    const Ctx c = make_ctx();
    for (int t = c.gw; t < T; t += c.NGW) {
        const f32x4* xr = (const f32x4*)(xin + (size_t)t * D) + c.lane;
        f32x4 v[8]; float ss = 0.f;
#pragma unroll
        for (int j = 0; j < 8; ++j) { v[j] = xr[64 * j]; ss += (v[j][0] * v[j][0] + v[j][1] * v[j][1]) + (v[j][2] * v[j][2] + v[j][3] * v[j][3]); }
        const float rstd = 1.0f / sqrtf(wave_sum(ss) * (1.0f / D) + EPS);
        const f32x4* gp = (const f32x4*)g + c.lane; f32x4* o = (f32x4*)(out + (size_t)t * D) + c.lane;
#pragma unroll
        for (int j = 0; j < 8; ++j) o[64 * j] = v[j] * rstd * gp[64 * j];
    }
}

__device__ __forceinline__ void dot8(const bf16* A, int lda, int t0, const float* W, int ldw, int col, int K, float (&acc)[8]) {
    for (int k = 0; k < K; ++k) { const float w = W[(size_t)k * ldw + col];
#pragma unroll
        for (int r = 0; r < 8; ++r) acc[r] += bf2f(A[(size_t)(t0 + r) * lda + k]) * w; }
}
__device__ __forceinline__ void naive_proj(KP p, int l) { const Ctx c = make_ctx();
    const bf16* HN = (const bf16*)(p->ws + WS_HN); bf16* PROJ = (bf16*)(p->ws + WS_PROJ); const float* W = p->w_in + (size_t)l * D * PIN; const float* rope = (const float*)(p->ws + WS_ROPE);
    for (int idx = c.gtid; idx < (T / 8) * NPROJ; idx += c.NT) {
        const int tb = idx / NPROJ, j = idx - tb * NPROJ, t0 = tb * 8; const int sc = win_src_col(j);
        float acc[8], acc2[8];
#pragma unroll
        for (int r = 0; r < 8; ++r) { acc[r] = 0.f; acc2[r] = 0.f; }
        if (sc >= 0) dot8(HN, D, t0, W, PIN, sc, D, acc);
        const bool rot = (j >= 4096 && j < 5120);
        if (rot) dot8(HN, D, t0, W, PIN, win_src_col(j ^ 1), D, acc2);
#pragma unroll
        for (int r = 0; r < 8; ++r) { const int t = t0 + r; float v = acc[r];
            if (rot) { const int pos = t & (SEQ - 1), i = (j & 127) >> 1; const float cs = rope[((size_t)pos * 64 + i) * 2], sn = rope[((size_t)pos * 64 + i) * 2 + 1];
                v = (j & 1) ? (acc[r] * cs + acc2[r] * sn) : (acc[r] * cs - acc2[r] * sn); }
            else if (j >= OFF_GATE) v = 1.0f / (1.0f + __expf(-v));
            PROJ[(size_t)t * NPROJ + j] = (bf16)f2bf(v); }
    }
}
__device__ __forceinline__ void naive_branch(KP p, int l) { const Ctx c = make_ctx();
    const bf16* PROJ = (const bf16*)(p->ws + WS_PROJ); const bf16* OBR = (const bf16*)(p->ws + WS_OBR); bf16* Y = (bf16*)(p->ws + WS_Y);
    for (int idx = c.gtid; idx < (T / 8) * D; idx += c.NT) { const int tb = idx / D, d = idx - tb * D, t0 = tb * 8;
        float y[8];
#pragma unroll
        for (int r = 0; r < 8; ++r) y[r] = 0.f;
        for (int i = 0; i < 4; ++i) { float acc[8];
#pragma unroll
            for (int r = 0; r < 8; ++r) acc[r] = 0.f;
            dot8(OBR + (size_t)i * T * BRW, BRW, t0, p->w_branch + ((size_t)l * 4 + i) * BRW * D, D, d, BRW, acc);
#pragma unroll
            for (int r = 0; r < 8; ++r) y[r] += bf2f(PROJ[(size_t)(t0 + r) * NPROJ + OFF_GATE + i * D + d]) * acc[r]; }
#pragma unroll
        for (int r = 0; r < 8; ++r) Y[(size_t)(t0 + r) * D + d] = (bf16)f2bf(y[r]); }
}
__device__ __forceinline__ void naive_wo(KP p, int l, const float* xin) { const Ctx c = make_ctx();
    const bf16* Y = (const bf16*)(p->ws + WS_Y); float* X = (float*)(p->ws + WS_X); const float* g1 = (const float*)(p->ws + WS_MOD) + (size_t)l * NBATCH * 12288 + 2 * D;
    for (int idx = c.gtid; idx < (T / 8) * D; idx += c.NT) { const int tb = idx / D, d = idx - tb * D, t0 = tb * 8;
        float acc[8];
#pragma unroll
        for (int r = 0; r < 8; ++r) acc[r] = 0.f;
        dot8(Y, D, t0, p->w_o + (size_t)l * D * D, D, d, D, acc);
#pragma unroll
        for (int r = 0; r < 8; ++r) { const int t = t0 + r; X[(size_t)t * D + d] = xin[(size_t)t * D + d] + g1[(size_t)(t >> 11) * 12288 + d] * acc[r]; } }
}
__device__ __forceinline__ void naive_wq(KP p, int l) { const Ctx c = make_ctx();
    const bf16* HN = (const bf16*)(p->ws + WS_HN); bf16* QP = (bf16*)(p->ws + WS_QP);
    for (int idx = c.gtid; idx < (T / 8) * D; idx += c.NT) { const int tb = idx / D, d = idx - tb * D, t0 = tb * 8;
        float acc[8];
#pragma unroll
        for (int r = 0; r < 8; ++r) acc[r] = 0.f;
        dot8(HN, D, t0, p->peer_wq + (size_t)l * D * D, D, d, D, acc);
#pragma unroll
        for (int r = 0; r < 8; ++r) QP[(size_t)(t0 + r) * D + d] = (bf16)f2bf(acc[r]); }
}

__device__ __forceinline__ void phase_conv(KP p, int l) { const Ctx c = make_ctx();
    const bf16* PROJ = (const bf16*)(p->ws + WS_PROJ); bf16* OA = (bf16*)(p->ws + WS_OBR); const float* cw = p->conv_w + (size_t)l * 3 * BRW;
    for (int idx0 = c.gtid; idx0 < T * 64; idx0 += 2 * c.NT) {
        u32x4 ov[2];
#pragma unroll
        for (int it = 0; it < 2; ++it) { const int idx = idx0 + it * c.NT; const int idc = idx < T * 64 ? idx : idx0; const int t = idc >> 6, c0 = (idc & 63) * 8, s = t & (SEQ - 1);
            float y[8];
#pragma unroll
            for (int q = 0; q < 8; ++q) y[q] = 0.f;
#pragma unroll
            for (int w = 0; w < 3; ++w) { if (s - 2 + w < 0) continue; const bf16* rp = PROJ + (size_t)(t - 2 + w) * NPROJ + OFF_A;
                const u32x4 gc = *(const u32x4*)(rp + 512 + c0), hv = *(const u32x4*)(rp + 1024 + c0);
                const f32x4 w0 = *(const f32x4*)(cw + w * BRW + c0), w1 = *(const f32x4*)(cw + w * BRW + c0 + 4);
                y[0] += w0[0] * bflo(gc.x) * bflo(hv.x); y[1] += w0[1] * bfhi(gc.x) * bfhi(hv.x); y[2] += w0[2] * bflo(gc.y) * bflo(hv.y); y[3] += w0[3] * bfhi(gc.y) * bfhi(hv.y);
                y[4] += w1[0] * bflo(gc.z) * bflo(hv.z); y[5] += w1[1] * bfhi(gc.z) * bfhi(hv.z); y[6] += w1[2] * bflo(gc.w) * bflo(hv.w); y[7] += w1[3] * bfhi(gc.w) * bfhi(hv.w); }
            const u32x4 gb = *(const u32x4*)(PROJ + (size_t)t * NPROJ + OFF_A + c0);
            ov[it].x = pk2(bflo(gb.x) * y[0], bfhi(gb.x) * y[1]); ov[it].y = pk2(bflo(gb.y) * y[2], bfhi(gb.y) * y[3]); ov[it].z = pk2(bflo(gb.z) * y[4], bfhi(gb.z) * y[5]); ov[it].w = pk2(bflo(gb.w) * y[6], bfhi(gb.w) * y[7]); }
#pragma unroll
        for (int it = 0; it < 2; ++it) { const int idx = idx0 + it * c.NT; if (idx < T * 64) *(u32x4*)(OA + (size_t)(idx >> 6) * BRW + (idx & 63) * 8) = ov[it]; }
    }
}
constexpr int SGS = 136;
__device__ __forceinline__ void phase_sg(KP p, int l) {
    const Ctx c = make_ctx();
    const bf16* PROJ = (const bf16*)(p->ws + WS_PROJ); bf16* OB = (bf16*)(p->ws + WS_OBR) + (size_t)1 * T * BRW;
    const float* ng = p->sg_norm_g + (size_t)l * BRW; const float* sw = p->sg_w + (size_t)l * 4 * 128 * 128; const float* sb = p->sg_b + (size_t)l * 4 * 128;
    LAS float* rstd = (LAS float*)c.lds; LAS bf16* vnT = (LAS bf16*)(c.lds + 1024);
    const int fr = c.lane & 15, g = c.lane >> 4;
    for (int u0 = blockIdx.x; u0 < 256; u0 += c.G) { const int u = (c.G == 256) ? ((u0 & 7) * 32 + (u0 >> 3)) : u0;
        const int hp = u & 1, t0 = (u >> 1) * 128;
        __syncthreads();
        for (int r = c.wave; r < 128; r += NWAVES) { const u32x4 vv = *(const u32x4*)(PROJ + (size_t)(t0 + r) * NPROJ + OFF_SG + 512 + c.lane * 8);
            float ss = bflo(vv.x) * bflo(vv.x) + bfhi(vv.x) * bfhi(vv.x) + bflo(vv.y) * bflo(vv.y) + bfhi(vv.y) * bfhi(vv.y) + bflo(vv.z) * bflo(vv.z) + bfhi(vv.z) * bfhi(vv.z) + bflo(vv.w) * bflo(vv.w) + bfhi(vv.w) * bfhi(vv.w);
            ss = wave_sum(ss); if (c.lane == 0) rstd[r] = 1.0f / sqrtf(ss * (1.0f / BRW) + EPS); }
        __syncthreads();
        for (int item = c.tid; item < 4096; item += NTHR) { const int sp = item & 127, cl = (item >> 7) * 8;
            const u32x4 w = *(const u32x4*)(PROJ + (size_t)(t0 + sp) * NPROJ + OFF_SG + 512 + hp * 256 + cl); const float rs = rstd[sp];
            const f32x4 g0 = *(const f32x4*)(ng + hp * 256 + cl), g1 = *(const f32x4*)(ng + hp * 256 + cl + 4);
            LAS bf16* dst = vnT + cl * SGS + sp;
            dst[0 * SGS] = (bf16)f2bf(bflo(w.x) * rs * g0[0]); dst[1 * SGS] = (bf16)f2bf(bfhi(w.x) * rs * g0[1]); dst[2 * SGS] = (bf16)f2bf(bflo(w.y) * rs * g0[2]); dst[3 * SGS] = (bf16)f2bf(bfhi(w.y) * rs * g0[3]);
            dst[4 * SGS] = (bf16)f2bf(bflo(w.z) * rs * g1[0]); dst[5 * SGS] = (bf16)f2bf(bfhi(w.z) * rs * g1[1]); dst[6 * SGS] = (bf16)f2bf(bflo(w.w) * rs * g1[2]); dst[7 * SGS] = (bf16)f2bf(bfhi(w.w) * rs * g1[3]); }
        __syncthreads();
        const int nks = (c.wave >> 1) + 1, tt = 16 * c.wave + fr;
#pragma unroll 1
        for (int hh = 0; hh < 2; ++hh) { const int gh = 2 * hp + hh;
            f32x4 acc[8];
#pragma unroll
            for (int ct = 0; ct < 8; ++ct) acc[ct] = (f32x4){0.f, 0.f, 0.f, 0.f};
            bf16 uv[4][8]; float bbv[4];
#pragma unroll
            for (int j = 0; j < 4; ++j) { const int t = 16 * c.wave + 4 * g + j; bbv[j] = sb[gh * 128 + t];
                const bf16* up = PROJ + (size_t)(t0 + t) * NPROJ + OFF_SG + hp * 256 + hh * 128 + fr;
#pragma unroll
                for (int ct = 0; ct < 8; ++ct) uv[j][ct] = up[16 * ct]; }
            asm volatile("" ::: "memory");
            for (int ks = 0; ks < nks; ++ks) { const int s0 = 32 * ks + 8 * g; const float* wp = sw + ((size_t)(gh * 128 + tt) * 128 + s0);
                const f32x4 wa = *(const f32x4*)wp, wb = *(const f32x4*)(wp + 4);
                u32x4 aw; aw.x = pk2(s0 + 0 <= tt ? wa[0] : 0.f, s0 + 1 <= tt ? wa[1] : 0.f); aw.y = pk2(s0 + 2 <= tt ? wa[2] : 0.f, s0 + 3 <= tt ? wa[3] : 0.f);
                aw.z = pk2(s0 + 4 <= tt ? wb[0] : 0.f, s0 + 5 <= tt ? wb[1] : 0.f); aw.w = pk2(s0 + 6 <= tt ? wb[2] : 0.f, s0 + 7 <= tt ? wb[3] : 0.f);
                const bf16x8 af = __builtin_bit_cast(bf16x8, aw);
#pragma unroll
                for (int ct = 0; ct < 8; ++ct) { const bf16x8 bfr = *(const LAS bf16x8*)(vnT + (hh * 128 + ct * 16 + fr) * SGS + 32 * ks + 8 * g);
                    acc[ct] = __builtin_amdgcn_mfma_f32_16x16x32_bf16(af, bfr, acc[ct], 0, 0, 0); } }
#pragma unroll
            for (int j = 0; j < 4; ++j) { const int t = 16 * c.wave + 4 * g + j; const float bb = bbv[j];
                bf16* op = OB + (size_t)(t0 + t) * BRW + hp * 256 + hh * 128 + fr;
#pragma unroll
                for (int ct = 0; ct < 8; ++ct) op[16 * ct] = (bf16)f2bf(bf2f(uv[j][ct]) * (acc[ct][j] + bb)); }
        }
    }
    __syncthreads();
}
__device__ __forceinline__ void naive_band(KP p, int l) { const Ctx c = make_ctx();
    const bf16* PROJ = (const bf16*)(p->ws + WS_PROJ); bf16* OC = (bf16*)(p->ws + WS_OBR) + (size_t)2 * T * BRW; const float* rb = p->rel_bias + (size_t)l * 4 * 257;
    for (int item = c.gw; item < T * 4; item += c.NGW) { const int t = item >> 2, h = item & 3, b = t >> 11, s = t & (SEQ - 1), n = s >> 6;
        const int ks0 = (n > 8 ? n - 8 : 0) * 64, ks1 = (n + 1) * 64;
        const unsigned qw = *(const unsigned*)(PROJ + (size_t)t * NPROJ + OFF_BAND + h * 128 + 2 * c.lane); const float q0 = bflo(qw), q1 = bfhi(qw);
        float m = -INFINITY, ls = 0.f, o0 = 0.f, o1 = 0.f;
        for (int kp = ks0; kp < ks1; ++kp) { const bf16* kr = PROJ + (size_t)(b * SEQ + kp) * NPROJ + OFF_BAND + h * 128 + 2 * c.lane;
            const unsigned kw = *(const unsigned*)(kr + 512), vw = *(const unsigned*)(kr + 1024);
            int dd = s - kp; dd = dd < -128 ? -128 : (dd > 128 ? 128 : dd);
            const float sc = wave_sum(q0 * bflo(kw) + q1 * bfhi(kw)) * 0.08838834764831845f + rb[h * 257 + dd + 128];
            const float mn = fmaxf(m, sc), corr = __expf(m - mn), pv = __expf(sc - mn);
            ls = ls * corr + pv; o0 = o0 * corr + pv * bflo(vw); o1 = o1 * corr + pv * bfhi(vw); m = mn; }
        const float inv = 1.0f / ls;
        *(unsigned*)(OC + (size_t)t * BRW + h * 128 + 2 * c.lane) = pk2(o0 * inv, o1 * inv); }
}
__device__ __forceinline__ unsigned f2sortable(float f) { const unsigned u = __float_as_uint(f); return (u & 0x80000000u) ? ~u : (u | 0x80000000u); }
__device__ __forceinline__ void naive_d1(KP p, int l) { const Ctx c = make_ctx();
    const bf16* PROJ = (const bf16*)(p->ws + WS_PROJ); unsigned* MASK = (unsigned*)(p->ws + WS_MASK);
    LAS float* qis = (LAS float*)(c.lds + c.wave * 16384); LAS float* scs = qis + 1088;
    for (int t = c.gw; t < T; t += c.NGW) { const int b = t >> 11, s = t & (SEQ - 1), n = s >> 6, nk = (n + 1) * 64, nkj = n + 1;
        for (int i = c.lane; i < 1040; i += 64) qis[i] = bf2f(PROJ[(size_t)t * NPROJ + OFF_QI + (i < 1024 ? i : (OFF_WI - OFF_QI) + (i - 1024))]);
        LDS_WAIT();
        for (int kb = 0; kb < nk; kb += 64) { const bf16* kr = PROJ + (size_t)(b * SEQ + kb + c.lane) * NPROJ + OFF_KI;
            float ki[64];
#pragma unroll
            for (int q = 0; q < 8; ++q) { const u32x4 w = *(const u32x4*)(kr + 8 * q); ki[8 * q] = bflo(w.x); ki[8 * q + 1] = bfhi(w.x); ki[8 * q + 2] = bflo(w.y); ki[8 * q + 3] = bfhi(w.y); ki[8 * q + 4] = bflo(w.z); ki[8 * q + 5] = bfhi(w.z); ki[8 * q + 6] = bflo(w.w); ki[8 * q + 7] = bfhi(w.w); }
            float score = 0.f;
            for (int hi = 0; hi < 16; ++hi) { float dot = 0.f;
#pragma unroll
                for (int d = 0; d < 64; ++d) dot += qis[hi * 64 + d] * ki[d];
                score += fmaxf(dot * 0.125f, 0.f) * (qis[1024 + hi] * 0.25f); }
            scs[kb + c.lane] = score; }
        LDS_WAIT();
        unsigned* mrow = MASK + (size_t)t * 64;
        if (nk <= 256) { mrow[c.lane] = (c.lane < 2 * nkj) ? 0xffffffffu : 0u; }
        else {
            unsigned u[32];
#pragma unroll
            for (int j = 0; j < 32; ++j) u[j] = (j < nkj) ? f2sortable(scs[64 * j + c.lane]) : 0u;
            unsigned thr = 0u;
            for (int bit = 31; bit >= 0; --bit) { const unsigned cand = thr | (1u << bit); int cnt = 0;
#pragma unroll
                for (int j = 0; j < 32; ++j) if (j < nkj) cnt += __popcll(__ballot(u[j] >= cand));
                if (cnt >= 256) thr = cand; }
            int cgt = 0;
#pragma unroll
            for (int j = 0; j < 32; ++j) if (j < nkj) cgt += __popcll(__ballot(u[j] > thr));
            const int need = 256 - cgt; int taken = 0;
            const unsigned long long ltmask = (c.lane == 0) ? 0ull : (~0ull >> (64 - c.lane));
#pragma unroll
            for (int j = 0; j < 32; ++j) { unsigned long long selm = 0ull;
                if (j < nkj) { const bool eq = (u[j] == thr); const unsigned long long eqm = __ballot(eq);
                    const bool sel = (u[j] > thr) || (eq && (taken + __popcll(eqm & ltmask)) < need); taken += __popcll(eqm); selm = __ballot(sel); }
                if (c.lane == 0) { mrow[2 * j] = (unsigned)selm; mrow[2 * j + 1] = (unsigned)(selm >> 32); } }
        }
    }
}
__device__ __forceinline__ void naive_d2(KP p, int l) { const Ctx c = make_ctx();
    const bf16* PROJ = (const bf16*)(p->ws + WS_PROJ); const unsigned* MASK = (const unsigned*)(p->ws + WS_MASK); bf16* OD = (bf16*)(p->ws + WS_OBR) + (size_t)3 * T * BRW;
    LAS float* qs = (LAS float*)(c.lds + c.wave * 16384); LAS float* sb = qs + 128;
    for (int t = c.gw; t < T; t += c.NGW) { const int b = t >> 11, s = t & (SEQ - 1), n = s >> 6, nk = (n + 1) * 64;
        for (int h = 0; h < 4; ++h) {
            { const unsigned qw = *(const unsigned*)(PROJ + (size_t)t * NPROJ + OFF_DSA + h * 128 + 2 * c.lane); qs[2 * c.lane] = bflo(qw); qs[2 * c.lane + 1] = bfhi(qw); }
            LDS_WAIT();
            float mx = -INFINITY;
            for (int kb = 0; kb < nk; kb += 64) { const int key = kb + c.lane; const unsigned mw = MASK[(size_t)t * 64 + (key >> 5)]; const bool sel = (mw >> (key & 31)) & 1u;
                float dot = -INFINITY;
                if (sel) { const bf16* kr = PROJ + (size_t)(b * SEQ + key) * NPROJ + OFF_DSA + 512 + h * 128; dot = 0.f;
#pragma unroll
                    for (int q = 0; q < 16; ++q) { const u32x4 w = *(const u32x4*)(kr + 8 * q);
                        dot += qs[8 * q] * bflo(w.x) + qs[8 * q + 1] * bfhi(w.x) + qs[8 * q + 2] * bflo(w.y) + qs[8 * q + 3] * bfhi(w.y) + qs[8 * q + 4] * bflo(w.z) + qs[8 * q + 5] * bfhi(w.z) + qs[8 * q + 6] * bflo(w.w) + qs[8 * q + 7] * bfhi(w.w); }
                    dot *= 0.08838834764831845f; }
                sb[key] = dot; mx = fmaxf(mx, dot); }
            mx = wave_max(mx);
            float ls = 0.f;
            for (int kb = 0; kb < nk; kb += 64) { const float sv = sb[kb + c.lane]; const float pv = (sv == -INFINITY) ? 0.f : __expf(sv - mx); sb[kb + c.lane] = pv; ls += pv; }
            ls = wave_sum(ls);
            LDS_WAIT();
            float o0 = 0.f, o1 = 0.f;
            for (int key = 0; key < nk; ++key) { const float pv = sb[key];
                if (pv != 0.f) { const unsigned vw = *(const unsigned*)(PROJ + (size_t)(b * SEQ + key) * NPROJ + OFF_DSA + 1024 + h * 128 + 2 * c.lane); o0 += pv * bflo(vw); o1 += pv * bfhi(vw); } }
            const float inv = 1.0f / ls;
            *(unsigned*)(OD + (size_t)t * BRW + h * 128 + 2 * c.lane) = pk2(o0 * inv, o1 * inv);
            LDS_WAIT();
        }
    }
}

typedef short s16x4 __attribute__((ext_vector_type(4)));
__device__ __forceinline__ s16x4 lds_tr16(const LAS bf16* p) { return __builtin_bit_cast(s16x4, __builtin_amdgcn_ds_read_tr16_b64_v4i16((LAS s16x4*)p)); }
constexpr int VST = 144;
constexpr int KST = 136;
constexpr int ATT_KBUF = 32 * KST * 2, ATT_VBUF = 32 * VST * 2;
constexpr int ATT_V_OFF = 4 * ATT_KBUF;
constexpr int ATT_BIAS_OFF = ATT_V_OFF + 4 * ATT_VBUF;
#define WG_BAR_LDS() do { asm volatile("s_waitcnt lgkmcnt(0)" ::: "memory"); __builtin_amdgcn_s_barrier(); asm volatile("" ::: "memory"); } while (0)
template <int MODE>
__device__ __forceinline__ void attn_unit(const Ctx& c, const bf16* PROJ, const int qoff, const unsigned* MASK, bf16* OUT, const int b, const int n, const int hp) {
    const int hl = c.wave >> 2, h = 2 * hp + hl, q4 = c.wave & 3, r0 = q4 * 16, fr = c.lane & 15, g = c.lane >> 4;
    const int tq = b * SEQ + n * 64 + r0 + fr;
    const int koff = qoff + 512 + h * 128, voff = qoff + 1024 + h * 128;
    bf16x8 qf[4];
#pragma unroll
    for (int ks = 0; ks < 4; ++ks) qf[ks] = *(const bf16x8*)(PROJ + (size_t)tq * NPROJ + qoff + h * 128 + 32 * ks + 8 * g);
    f32x4 O[8];
#pragma unroll
    for (int dt = 0; dt < 8; ++dt) O[dt] = (f32x4){0.f, 0.f, 0.f, 0.f};
    float m = -1e30f, lsum = 0.f;
    const int kbeg = (MODE == 0) ? (n > 8 ? n - 8 : 0) * 64 : 0, kend = (n + 1) * 64, nsteps = (kend - kbeg) >> 5;
    LAS bf16* kls = (LAS bf16*)c.lds + (size_t)(hl * 2) * 32 * KST;
    LAS bf16* vls = (LAS bf16*)(c.lds + ATT_V_OFF) + (size_t)(hl * 2) * 32 * VST;
    const LAS float* bias = (const LAS float*)(c.lds + ATT_BIAS_OFF) + hl * 257;
    const int qpos = n * 64 + r0 + fr;
    const bf16* kvbase = PROJ + (size_t)(b * SEQ) * NPROJ;
    u32x4 rkA[2], rvA[2], rkB[2], rvB[2];
    const int cid0 = q4 * 128 + c.lane;
    const unsigned lof0 = (unsigned)((cid0 >> 4) * NPROJ + (cid0 & 15) * 8) * 2u, lof1 = (unsigned)(((cid0 + 64) >> 4) * NPROJ + ((cid0 + 64) & 15) * 8) * 2u;
#define LOADG(RK, RV, kb) do { const int _kb = (kb) < kend - 32 ? (kb) : kend - 32; size_t _ko = ((size_t)(b * SEQ + _kb) * NPROJ + koff) * 2, _vo = ((size_t)(b * SEQ + _kb) * NPROJ + voff) * 2; asm volatile("" : "+s"(_ko), "+s"(_vo)); \
        const unsigned char* _kp = (const unsigned char*)PROJ + _ko; const unsigned char* _vp = (const unsigned char*)PROJ + _vo; \
        RK[0] = *(const u32x4*)(_kp + lof0); RK[1] = *(const u32x4*)(_kp + lof1); RV[0] = *(const u32x4*)(_vp + lof0); RV[1] = *(const u32x4*)(_vp + lof1); } while (0)
#define WRITEL(RK, RV, buf) do { _Pragma("unroll") for (int _i = 0; _i < 2; ++_i) { const int _cid = cid0 + 64 * _i; \
        *(LAS u32x4*)(kls + (buf) * 32 * KST + (_cid >> 4) * KST + (_cid & 15) * 8) = RK[_i]; *(LAS u32x4*)(vls + (buf) * 32 * VST + (_cid >> 4) * VST + (_cid & 15) * 8) = RV[_i]; } } while (0)
    unsigned mwn = 0u; if (MODE == 1) mwn = MASK[(size_t)tq * 64 + (kbeg >> 5)];
    LOADG(rkA, rvA, kbeg); WRITEL(rkA, rvA, 0); LOADG(rkB, rvB, kbeg + 32); LOADG(rkA, rvA, kbeg + 64);
    WG_BAR_LDS();
    auto step = [&](const int kb, const int buf) {
        const LAS bf16* Kb = kls + buf * 32 * KST; const LAS bf16* Vb = vls + buf * 32 * VST;
        f32x4 sa = (f32x4){0.f, 0.f, 0.f, 0.f}, sb = sa;
#pragma unroll
        for (int ks = 0; ks < 4; ++ks) { const bf16x8 ka = *(const LAS bf16x8*)(Kb + fr * KST + 32 * ks + 8 * g), kc = *(const LAS bf16x8*)(Kb + (16 + fr) * KST + 32 * ks + 8 * g);
            sa = __builtin_amdgcn_mfma_f32_16x16x32_bf16(ka, qf[ks], sa, 0, 0, 0); sb = __builtin_amdgcn_mfma_f32_16x16x32_bf16(kc, qf[ks], sb, 0, 0, 0); }
        float sv[8];
        if (MODE == 0) { const int d0 = qpos - (kb + 4 * g);
#pragma unroll
            for (int j = 0; j < 4; ++j) { int da = d0 - j, db = d0 - 16 - j; da = da > 128 ? 128 : da; db = db > 128 ? 128 : db;
                sv[j] = sa[j] * 0.12751743f + bias[da + 128]; sv[4 + j] = sb[j] * 0.12751743f + bias[db + 128]; } }
        else { const unsigned mw = mwn >> (4 * g); { const int wn = (kb >> 5) + 1; mwn = MASK[(size_t)tq * 64 + (wn < (kend >> 5) ? wn : (kend >> 5) - 1)]; }
#pragma unroll
            for (int j = 0; j < 4; ++j) { sv[j] = ((mw >> j) & 1u) ? sa[j] * 0.12751743f : -INFINITY; sv[4 + j] = ((mw >> (16 + j)) & 1u) ? sb[j] * 0.12751743f : -INFINITY; } }
        float mx = fmaxf(fmaxf(fmaxf(sv[0], sv[1]), fmaxf(sv[2], sv[3])), fmaxf(fmaxf(sv[4], sv[5]), fmaxf(sv[6], sv[7])));
        mx = fmaxf(mx, __shfl_xor(mx, 16)); mx = fmaxf(mx, __shfl_xor(mx, 32));
        const float mn = fmaxf(m, mx), corr = __builtin_amdgcn_exp2f(m - mn);
        const bool grew = mn > m; m = mn;
        float ps = 0.f;
#pragma unroll
        for (int j = 0; j < 8; ++j) { sv[j] = __builtin_amdgcn_exp2f(sv[j] - mn); ps += sv[j]; }
        lsum = lsum * corr + ps;
        if (__ballot(grew) != 0ull) {
#pragma unroll
            for (int dt = 0; dt < 8; ++dt) O[dt] = O[dt] * corr; }
        u32x4 pw; pw.x = pg8::cvt_pk_bf16(sv[0], sv[1]); pw.y = pg8::cvt_pk_bf16(sv[2], sv[3]); pw.z = pg8::cvt_pk_bf16(sv[4], sv[5]); pw.w = pg8::cvt_pk_bf16(sv[6], sv[7]);
        const bf16x8 pf = __builtin_bit_cast(bf16x8, pw);
        const LAS bf16* vr = Vb + (4 * g + (fr >> 2)) * VST + 4 * (fr & 3);
#pragma unroll
        for (int dt = 0; dt < 8; ++dt) { const s16x4 va = lds_tr16(vr + 16 * dt), vb = lds_tr16(vr + 16 * VST + 16 * dt);
            const bf16x8 vf = (bf16x8){va[0], va[1], va[2], va[3], vb[0], vb[1], vb[2], vb[3]};
            O[dt] = __builtin_amdgcn_mfma_f32_16x16x32_bf16(vf, pf, O[dt], 0, 0, 0); }
    };
    for (int st = 0; st < nsteps; st += 2) { const int kb = kbeg + 32 * st;
        step(kb, 0);      WRITEL(rkB, rvB, 1); LOADG(rkB, rvB, kb + 96);  WG_BAR_LDS();
        step(kb + 32, 1); WRITEL(rkA, rvA, 0); LOADG(rkA, rvA, kb + 128); WG_BAR_LDS();
    }
#undef LOADG
#undef WRITEL
    lsum += __shfl_xor(lsum, 16); lsum += __shfl_xor(lsum, 32);
    const float inv = 1.0f / lsum;
    bf16* op = OUT + (size_t)tq * BRW + h * 128 + 4 * g;
#pragma unroll
    for (int dt = 0; dt < 8; ++dt) { u32x2 w; w.x = pg8::cvt_pk_bf16(O[dt][0] * inv, O[dt][1] * inv); w.y = pg8::cvt_pk_bf16(O[dt][2] * inv, O[dt][3] * inv); *(u32x2*)(op + 16 * dt) = w; }
}
__device__ __forceinline__ void phase_band(KP p, int l) {
    const Ctx c = make_ctx();
    const bf16* PROJ = (const bf16*)(p->ws + WS_PROJ); bf16* OC = (bf16*)(p->ws + WS_OBR) + (size_t)2 * T * BRW; const float* rb = p->rel_bias + (size_t)l * 4 * 257;
    LAS float* bias = (LAS float*)(c.lds + ATT_BIAS_OFF);
    for (int u0 = blockIdx.x; u0 < 512; u0 += c.G) { const int u = (c.G == 256) ? ((u0 & 7) * 64 + (u0 >> 8) * 32 + ((u0 >> 3) & 31)) : u0;
        const int hp = u & 1, n = (u >> 1) & 31, b = u >> 6;
        __syncthreads();
        for (int i = c.tid; i < 2 * 257; i += NTHR) bias[i] = rb[(2 * hp) * 257 + i] * 1.4426950408889634f;
        __syncthreads();
        attn_unit<0>(c, PROJ, OFF_BAND, nullptr, OC, b, n, hp);
    }
    __syncthreads();
}
__device__ __forceinline__ void phase_d2(KP p, int l) {
    const Ctx c = make_ctx();
    const bf16* PROJ = (const bf16*)(p->ws + WS_PROJ); bf16* OD = (bf16*)(p->ws + WS_OBR) + (size_t)3 * T * BRW; const unsigned* MASK = (const unsigned*)(p->ws + WS_MASK);
    for (int i = blockIdx.x; i < 512; i += c.G) {
        int n, b, hp;
        if (c.G == 256) { const int idx = (i >> 3) & 31, r = i >> 8; b = i & 7; hp = idx & 1; const int m = idx >> 1; n = r ? m : 31 - m; }
        else { const int rank = (i < 256) ? i : 767 - i; n = 31 - (rank >> 4); b = (rank & 15) >> 1; hp = rank & 1; }
        attn_unit<1>(c, PROJ, OFF_DSA, MASK, OD, b, n, hp);
    }
}
template <int NJ>
__device__ __forceinline__ void select_row_t(const LAS float* row, const int nkj, unsigned* mrow, const int lane, LAS unsigned* hb) {
    unsigned u[NJ];
#pragma unroll
    for (int j = 0; j < NJ; ++j) { const unsigned v = f2sortable(row[64 * j + lane]); u[j] = (j < nkj) ? v : 0u; }
    unsigned thr = 0u; int rk = 256;
#pragma unroll 1
    for (int pass = 0; pass < 4; ++pass) { const int shift = 24 - 8 * pass;
#pragma unroll
        for (int i = 0; i < 4; ++i) hb[lane + 64 * i] = 0u;
        const unsigned hmask = pass == 0 ? 0u : (0xffffffffu << (shift + 8));
#pragma unroll
        for (int j = 0; j < NJ; ++j) { const unsigned v = u[j]; if (v != 0u && ((v ^ thr) & hmask) == 0u) (void)__hip_atomic_fetch_add((unsigned*)(hb + ((v >> shift) & 255u)), 1u, __ATOMIC_RELAXED, __HIP_MEMORY_SCOPE_WORKGROUP); }
        asm volatile("s_waitcnt lgkmcnt(0)" ::: "memory");
        const unsigned c0 = hb[255 - 4 * lane], c1 = hb[254 - 4 * lane], c2 = hb[253 - 4 * lane], c3 = hb[252 - 4 * lane];
        const int ls = (int)(c0 + c1 + c2 + c3); int incl = ls;
#define SCAN_ADD(ctl, rmask, bc) incl += __builtin_amdgcn_update_dpp(0, incl, (ctl), (rmask), 0xf, (bc))
        SCAN_ADD(0x111, 0xf, true); SCAN_ADD(0x112, 0xf, true); SCAN_ADD(0x114, 0xf, true); SCAN_ADD(0x118, 0xf, true); SCAN_ADD(0x142, 0xa, false); SCAN_ADD(0x143, 0xc, false);
#undef SCAN_ADD
        const int excl = incl - ls;
        const unsigned long long hit = __ballot(excl < rk && rk <= incl);
        const int L = hit ? (int)__builtin_ctzll(hit) : 63;
        int run = __builtin_amdgcn_readlane(excl, L); const int b0 = __builtin_amdgcn_readlane((int)c0, L), b1 = __builtin_amdgcn_readlane((int)c1, L), b2 = __builtin_amdgcn_readlane((int)c2, L);
        int dsel = 255 - 4 * L;
        if (run + b0 < rk) { run += b0; --dsel; if (run + b1 < rk) { run += b1; --dsel; if (run + b2 < rk) { run += b2; --dsel; } } }
        rk -= run; thr |= (unsigned)dsel << shift; }
    int cgt = 0;
#pragma unroll
    for (int j = 0; j < NJ; ++j) cgt += __popcll(__ballot(u[j] > thr));
    const int need = 256 - cgt; int taken = 0;
    const unsigned long long ltmask = (lane == 0) ? 0ull : (~0ull >> (64 - lane));
#pragma unroll
    for (int j = 0; j < NJ; ++j) { const bool eq = (u[j] == thr); const unsigned long long eqm = __ballot(eq);
        const bool sel = (u[j] > thr) || (eq && (taken + __popcll(eqm & ltmask)) < need); taken += __popcll(eqm); const unsigned long long selm = __ballot(sel);
        if (lane == 0 && j < nkj) { mrow[2 * j] = (unsigned)selm; mrow[2 * j + 1] = (unsigned)(selm >> 32); } }
}
__device__ __forceinline__ void select_row(const LAS float* row, const int nkj, unsigned* mrow, const int lane, LAS unsigned* hb) {
    if (nkj <= 4) { if (lane < 2 * nkj) mrow[lane] = 0xffffffffu; return; }
    if (nkj <= 8) select_row_t<8>(row, nkj, mrow, lane, hb);
    else if (nkj <= 16) select_row_t<16>(row, nkj, mrow, lane, hb);
    else if (nkj <= 24) select_row_t<24>(row, nkj, mrow, lane, hb);
    else select_row_t<32>(row, nkj, mrow, lane, hb);
}
constexpr int SCS = 2052;
constexpr int D1_WIT_OFF = 16 * SCS * 4;
__device__ __forceinline__ void phase_d1(KP p, int l) {
    const Ctx c = make_ctx();
    const bf16* PROJ = (const bf16*)(p->ws + WS_PROJ); unsigned* MASK = (unsigned*)(p->ws + WS_MASK);
    LAS float* SC = (LAS float*)c.lds; LAS float* WIT = (LAS float*)(c.lds + D1_WIT_OFF);
    const int fr = c.lane & 15, g = c.lane >> 4;
    for (int i = blockIdx.x; i < 1024; i += c.G) {
        int n, b, qtr;
        if (c.G == 256) { const int idx = (i >> 3) & 31, r = i >> 8, m = idx >> 2; b = i & 7; qtr = idx & 3; n = (r == 0) ? 31 - m : (r == 1) ? 16 + m : (r == 2) ? 15 - m : m; }
        else { const int r = i >> 8, s = i & 255, rank = r * 256 + ((r & 1) ? 255 - s : s); n = 31 - (rank >> 5); b = (rank & 31) >> 2; qtr = rank & 3; }
        const int nk = (n + 1) * 64, t0 = b * SEQ + n * 64 + qtr * 16;
        __syncthreads();
        if (c.tid < 256) { const int q = c.tid & 15, hi = c.tid >> 4; WIT[hi * 16 + q] = bf2f(PROJ[(size_t)(t0 + q) * NPROJ + OFF_WI + hi]) * 0.25f; }
        bf16x8 af[16][2];
#pragma unroll
        for (int hi = 0; hi < 16; ++hi)
#pragma unroll
            for (int ks = 0; ks < 2; ++ks) af[hi][ks] = *(const bf16x8*)(PROJ + (size_t)(t0 + fr) * NPROJ + OFF_QI + hi * 64 + 32 * ks + 8 * g);
        __syncthreads();
        const int nkt = nk / 16;
#define D1_LOADK(dst, kt_) do { const int _kt = (kt_) < nkt ? (kt_) : nkt - 1; _Pragma("unroll") for (int ks = 0; ks < 2; ++ks) dst[ks] = *(const bf16x8*)(PROJ + (size_t)(b * SEQ + _kt * 16 + fr) * NPROJ + OFF_KI + 32 * ks + 8 * g); } while (0)
        bf16x8 bq0[2], bq1[2];
        D1_LOADK(bq0, c.wave); D1_LOADK(bq1, c.wave + NWAVES);
        for (int kt = c.wave; kt < nkt; kt += NWAVES) {
            bf16x8 bfr[2]; bfr[0] = bq0[0]; bfr[1] = bq0[1]; bq0[0] = bq1[0]; bq0[1] = bq1[1];
            D1_LOADK(bq1, kt + 2 * NWAVES);
            f32x4 score = (f32x4){0.f, 0.f, 0.f, 0.f};
#pragma unroll
            for (int hq = 0; hq < 16; hq += 4) {
                f32x4 acc[4];
#pragma unroll
                for (int d = 0; d < 4; ++d) acc[d] = __builtin_amdgcn_mfma_f32_16x16x32_bf16(af[hq + d][0], bfr[0], (f32x4){0.f, 0.f, 0.f, 0.f}, 0, 0, 0);
#pragma unroll
                for (int d = 0; d < 4; ++d) acc[d] = __builtin_amdgcn_mfma_f32_16x16x32_bf16(af[hq + d][1], bfr[1], acc[d], 0, 0, 0);
#pragma unroll
                for (int d = 0; d < 4; ++d) { const f32x4 w4 = *(const LAS f32x4*)(WIT + (hq + d) * 16 + 4 * g);
#pragma unroll
                    for (int j = 0; j < 4; ++j) score[j] += fmaxf(acc[d][j] * 0.125f, 0.f) * w4[j]; } }
#pragma unroll
            for (int j = 0; j < 4; ++j) SC[(4 * g + j) * SCS + kt * 16 + fr] = score[j];
        }
#undef D1_LOADK
        __syncthreads();
#pragma unroll 1
        for (int q2 = 0; q2 < 2; ++q2) { const int qq = c.wave * 2 + q2; select_row(SC + qq * SCS, n + 1, MASK + (size_t)(t0 + qq) * 64, c.lane, (LAS unsigned*)(c.lds + D1_WIT_OFF + 1024) + c.wave * 256); }
    }
    __syncthreads();
}

__device__ __forceinline__ void naive_psel(KP p, int l) { const Ctx c = make_ctx();
    const bf16* QP = (const bf16*)(p->ws + WS_QP); float* SC = (float*)(p->ws + WS_SC); int* SCI = (int*)(p->ws + WS_SCI);
    int* EIDX = (int*)(p->ws + WS_EIDX); float* GWT = (float*)(p->ws + WS_GW); const float* keys = p->peer_keys + (size_t)l * 262144;
    for (int item = c.gtid; item < T * 8; item += c.NT) { const int t = item >> 3, h = item & 7;
        float* sc = SC + (size_t)item * 256; int* sci = SCI + (size_t)item * 256;
        const bf16* qrow = QP + (size_t)t * D + h * 256;
        for (int pk = 0; pk < 256; ++pk) { const int ph = pk >> 7; const float* kr = keys + ((size_t)(h * 2 + ph) * 128 + (pk & 127)) * 128; float dot = 0.f;
            for (int d = 0; d < 128; ++d) dot += bf2f(qrow[ph * 128 + d]) * kr[d];
            sc[pk] = dot; }
        float sv0[16], sv1[16]; int si0[16], si1[16];
#pragma unroll
        for (int r = 0; r < 16; ++r) { float best = -INFINITY; int bi = 0;
            for (int k = 0; k < 128; ++k) { const float v = sc[k]; if (v > best) { best = v; bi = k; } }
            sv0[r] = best; si0[r] = bi; sc[bi] = -INFINITY; }
#pragma unroll
        for (int r = 0; r < 16; ++r) { float best = -INFINITY; int bi = 0;
            for (int k = 0; k < 128; ++k) { const float v = sc[128 + k]; if (v > best) { best = v; bi = k; } }
            sv1[r] = best; si1[r] = bi; sc[128 + bi] = -INFINITY; }
#pragma unroll
        for (int i = 0; i < 16; ++i)
#pragma unroll
            for (int j = 0; j < 16; ++j) { sc[i * 16 + j] = sv0[i] + sv1[j]; sci[i * 16 + j] = si0[i] * 128 + si1[j]; }
        float fv[16]; int fe[16];
#pragma unroll
        for (int r = 0; r < 16; ++r) { float best = -INFINITY; int bi = 0;
            for (int k = 0; k < 256; ++k) { const float v = sc[k]; if (v > best) { best = v; bi = k; } }
            fv[r] = best; fe[r] = sci[bi]; sc[bi] = -INFINITY; }
        float es[16], sum = 0.f;
#pragma unroll
        for (int r = 0; r < 16; ++r) { es[r] = __expf(fv[r] - fv[0]); sum += es[r]; }
        const float inv = 1.0f / sum;
#pragma unroll
        for (int r = 0; r < 16; ++r) { EIDX[(size_t)t * 128 + h * 16 + r] = fe[r]; GWT[(size_t)t * 128 + h * 16 + r] = es[r] * inv; }
    }
}

typedef __bf16 bf16x2_t __attribute__((ext_vector_type(2)));
__device__ __forceinline__ float dot2bf(unsigned a, unsigned b, float acc) { return __builtin_amdgcn_fdot2_f32_bf16(__builtin_bit_cast(bf16x2_t, a), __builtin_bit_cast(bf16x2_t, b), acc, false); }
__device__ __forceinline__ float from_sortable(unsigned u) { return __uint_as_float((u & 0x80000000u) ? (u & 0x7fffffffu) : ~u); }
__device__ __forceinline__ float gelu_tanh(float x) { const float u = 0.7978845608028654f * (x + 0.044715f * x * x * x); const float e = __expf(2.0f * u); return 0.5f * x * (1.0f + (1.0f - 2.0f / (e + 1.0f))); }
__device__ __forceinline__ void naive_pgather(KP p, int l) { const Ctx c = make_ctx();
    const bf16* HN = (const bf16*)(p->ws + WS_HN); float* X = (float*)(p->ws + WS_X); const int* EIDX = (const int*)(p->ws + WS_EIDX); const float* GWT = (const float*)(p->ws + WS_GW);
    const float* U = p->peer_u + (size_t)l * 16384 * D; const float* V = p->peer_v + (size_t)l * 16384 * D; const float* g2 = (const float*)(p->ws + WS_MOD) + (size_t)l * NBATCH * 12288 + 5 * D;
    for (int t = c.gw; t < T; t += c.NGW) {
        f32x4 hv[8], y[8];
#pragma unroll
        for (int j = 0; j < 8; ++j) { const u32x2 w = *((const u32x2*)(HN + (size_t)t * D) + c.lane + 64 * j); hv[j] = (f32x4){bflo(w.x), bfhi(w.x), bflo(w.y), bfhi(w.y)}; y[j] = (f32x4){0.f, 0.f, 0.f, 0.f}; }
        for (int e = 0; e < 128; ++e) { const int idx = EIDX[(size_t)t * 128 + e]; const float gwt = GWT[(size_t)t * 128 + e];
            const f32x4* ur = (const f32x4*)(U + (size_t)idx * D) + c.lane; float part = 0.f;
#pragma unroll
            for (int j = 0; j < 8; ++j) { const f32x4 uu = ur[64 * j]; part += (hv[j][0] * uu[0] + hv[j][1] * uu[1]) + (hv[j][2] * uu[2] + hv[j][3] * uu[3]); }
            const float a = wave_sum(part); const float hh = gelu_tanh(a) * gwt;
            const f32x4* vr = (const f32x4*)(V + (size_t)idx * D) + c.lane;
#pragma unroll
            for (int j = 0; j < 8; ++j) y[j] += vr[64 * j] * hh; }
        f32x4* xr = (f32x4*)(X + (size_t)t * D) + c.lane; const f32x4* gp = (const f32x4*)(g2 + (size_t)(t >> 11) * 12288) + c.lane;
#pragma unroll
        for (int j = 0; j < 8; ++j) xr[64 * j] = xr[64 * j] + gp[64 * j] * y[j];
    }
}

#define INS16(L, v) do { unsigned _v = (v); _Pragma("unroll") for (int _i = 0; _i < 16; ++_i) { const unsigned _t = max(L[_i], _v); _v = min(L[_i], _v); L[_i] = _t; } } while (0)
__device__ __forceinline__ void phase_psel(KP p, int l) {
    const Ctx c = make_ctx();
    const bf16* QP = (const bf16*)(p->ws + WS_QP); const bf16* KEYS = (const bf16*)(p->ws + WS_KEYS); int* EIDX = (int*)(p->ws + WS_EIDX); float* GWT = (float*)(p->ws + WS_GW);
    LAS unsigned* SL = (LAS unsigned*)c.lds;
    const int fr = c.lane & 15, fq = c.lane >> 4;
    for (int u = blockIdx.x; u < T / 64; u += c.G) { const int t0 = u * 64;
        for (int hp = 0; hp < 4; ++hp) {
            __syncthreads();
            {
                const int hh = c.wave >> 2, ph = (c.wave >> 1) & 1, th = c.wave & 1, h = 2 * hp + hh;
                bf16x8 af[2][4];
#pragma unroll
                for (int mt = 0; mt < 2; ++mt)
#pragma unroll
                    for (int ks = 0; ks < 4; ++ks) af[mt][ks] = *(const bf16x8*)(QP + (size_t)(t0 + th * 32 + mt * 16 + fr) * D + h * 256 + ph * 128 + ks * 32 + fq * 8);
                const bf16* kb = KEYS + (size_t)(h * 2 + ph) * 128 * 128;
                bf16x8 bfr[8][4];
#pragma unroll
                for (int nt = 0; nt < 8; ++nt)
#pragma unroll
                    for (int ks = 0; ks < 4; ++ks) bfr[nt][ks] = *(const bf16x8*)(kb + (size_t)(nt * 16 + fr) * 128 + ks * 32 + fq * 8);
#pragma unroll
                for (int nt = 0; nt < 8; ++nt) {
#pragma unroll
                    for (int mt = 0; mt < 2; ++mt) { f32x4 acc = (f32x4){0.f, 0.f, 0.f, 0.f};
#pragma unroll
                        for (int ks = 0; ks < 4; ++ks) acc = __builtin_amdgcn_mfma_f32_16x16x32_bf16(af[mt][ks], bfr[nt][ks], acc, 0, 0, 0);
#pragma unroll
                        for (int j = 0; j < 4; ++j) { const int tok = th * 32 + mt * 16 + fq * 4 + j, key = nt * 16 + fr;
                            SL[((tok * 2 + hh) * 2 + ph) * 129 + key] = (f2sortable(acc[j]) & ~127u) | (unsigned)key; } }
                }
            }
            __syncthreads();
            {
                unsigned L[16];
#pragma unroll
                for (int i = 0; i < 16; ++i) L[i] = 0u;
                LAS unsigned* row = SL + (c.tid >> 1) * 129; const LAS unsigned* hrow = row + (c.tid & 1) * 64;
                for (int k = 0; k < 64; k += 4) { const unsigned v0 = hrow[k], v1 = hrow[k + 1], v2 = hrow[k + 2], v3 = hrow[k + 3]; INS16(L, v0); INS16(L, v1); INS16(L, v2); INS16(L, v3); }
                unsigned M[16];
#pragma unroll
                for (int i = 0; i < 16; ++i) { const unsigned o = (unsigned)__builtin_amdgcn_mov_dpp((int)L[15 - i], 0xB1, 0xf, 0xf, true); M[i] = max(L[i], o); }
#pragma unroll
                for (int st = 8; st >= 1; st >>= 1)
#pragma unroll
                    for (int i = 0; i < 16; ++i) if ((i & st) == 0) { const unsigned a = M[i], b = M[i + st]; M[i] = max(a, b); M[i + st] = min(a, b); }
                __syncthreads();
                if ((c.tid & 1) == 0) {
#pragma unroll
                    for (int i = 0; i < 16; ++i) row[i] = M[i]; }
            }
            __syncthreads();
            if (c.tid < 256 && (c.tid & 1) == 0) {
                LAS unsigned* r0 = SL + c.tid * 129; LAS unsigned* r1 = r0 + 129;
                float s0[16], s1[16];
#pragma unroll
                for (int i = 0; i < 16; ++i) { s0[i] = from_sortable(r0[i] & ~127u); s1[i] = from_sortable(r1[i] & ~127u); }
                unsigned L[16];
#pragma unroll
                for (int i = 0; i < 16; ++i) L[i] = 0u;
#pragma unroll
                for (int i = 0; i < 16; ++i)
#pragma unroll
                    for (int j = 0; j < 16; ++j) if ((i + 1) * (j + 1) <= 16) { const unsigned v = (f2sortable(s0[i] + s1[j]) & ~255u) | (unsigned)(i * 16 + j); INS16(L, v); }
                float es[16], sum = 0.f; const float f0 = from_sortable(L[0] & ~255u);
#pragma unroll
                for (int r = 0; r < 16; ++r) { es[r] = __expf(from_sortable(L[r] & ~255u) - f0); sum += es[r]; }
                const float inv = 1.0f / sum; const int tok = c.tid >> 2, hh = (c.tid >> 1) & 1; const size_t ob = (size_t)(t0 + tok) * 128 + (2 * hp + hh) * 16;
#pragma unroll
                for (int r = 0; r < 16; ++r) { const int ij = L[r] & 255u; const int e = (int)(r0[ij >> 4] & 127u) * 128 + (int)(r1[ij & 15] & 127u); EIDX[ob + r] = e; GWT[ob + r] = es[r] * inv; }
            }
        }
    }
    __syncthreads();
}
__device__ __forceinline__ void phase_pgather_u(KP p, int l, size_t hdst) {
    const Ctx c = make_ctx();
    const bf16* HN = (const bf16*)(p->ws + WS_HN); float* X = (float*)(p->ws + WS_X); const int* EIDX = (const int*)(p->ws + WS_EIDX); const float* GWT = (const float*)(p->ws + WS_GW);
    const unsigned char* U8 = p->ws + WS_U; const unsigned char* V8 = p->ws + WS_V; const float* SU = (const float*)(p->ws + WS_SCL); const float* SV = SU + 16384;
    const float* g2 = (const float*)(p->ws + WS_MOD) + (size_t)l * NBATCH * 12288 + 5 * D;
    u32x4 xvn[4]; int e0n = 0, e1n = 0;
    if (c.gw < T) { e0n = EIDX[(size_t)c.gw * 128 + c.lane]; e1n = EIDX[(size_t)c.gw * 128 + 64 + c.lane];
#pragma unroll
        for (int j = 0; j < 2; ++j)
#pragma unroll
            for (int hh = 0; hh < 2; ++hh) xvn[2 * j + hh] = *((const u32x4*)(HN + (size_t)c.gw * D + 1024 * j + 16 * c.lane) + hh); }
    for (int t = c.gw; t < T; t += c.NGW) {
        float xf[32];
#pragma unroll
        for (int q = 0; q < 4; ++q) { const u32x4 w = xvn[q];
            xf[8 * q + 0] = bflo(w.x); xf[8 * q + 1] = bfhi(w.x); xf[8 * q + 2] = bflo(w.y); xf[8 * q + 3] = bfhi(w.y);
            xf[8 * q + 4] = bflo(w.z); xf[8 * q + 5] = bfhi(w.z); xf[8 * q + 6] = bflo(w.w); xf[8 * q + 7] = bfhi(w.w); }
        const int e0 = e0n, e1 = e1n;
        { const int tn = (t + c.NGW < T) ? t + c.NGW : t;
          e0n = EIDX[(size_t)tn * 128 + c.lane]; e1n = EIDX[(size_t)tn * 128 + 64 + c.lane];
#pragma unroll
          for (int j = 0; j < 2; ++j)
#pragma unroll
              for (int hh = 0; hh < 2; ++hh) xvn[2 * j + hh] = *((const u32x4*)(HN + (size_t)tn * D + 1024 * j + 16 * c.lane) + hh); }
        const float gw0 = GWT[(size_t)t * 128 + c.lane], gw1 = GWT[(size_t)t * 128 + 64 + c.lane];
        const float su0 = SU[e0], su1 = SU[e1], sv0 = SV[e0], sv1 = SV[e1];
        float a0 = 0.f, a1 = 0.f;
        u32x4 R[8][2];
#define ROWIDX(e) (((e) < 64) ? __builtin_amdgcn_readlane(e0, (e) & 63) : __builtin_amdgcn_readlane(e1, (e) & 63))
#define LOADROW(base, e, u) do { const int _ia = __builtin_amdgcn_readlane(e0, (e) & 63), _ib = __builtin_amdgcn_readlane(e1, (e) & 63); \
        const u32x4* _rp = (const u32x4*)((base) + (size_t)(((e) < 64) ? _ia : _ib) * 2048) + c.lane; R[u][0] = _rp[0]; R[u][1] = _rp[64]; } while (0)
#define UROW(u, e) do { float p0 = 0.f, p1 = 0.f, p2 = 0.f, p3 = 0.f; \
            _Pragma("unroll") for (int j = 0; j < 2; ++j) { const u32x4 rw = R[u][j]; const unsigned wd[4] = {rw.x, rw.y, rw.z, rw.w}; \
                _Pragma("unroll") for (int k = 0; k < 4; ++k) { const f32x2 lo = __builtin_amdgcn_cvt_pk_f32_fp8((int)wd[k], false), hi = __builtin_amdgcn_cvt_pk_f32_fp8((int)wd[k], true); \
                    p0 += lo.x * xf[16 * j + 4 * k]; p1 += lo.y * xf[16 * j + 4 * k + 1]; p2 += hi.x * xf[16 * j + 4 * k + 2]; p3 += hi.y * xf[16 * j + 4 * k + 3]; } } \
            upart = (p0 + p1) + (p2 + p3); } while (0)
#define UPUT(e) do { const float tot = wave_total(upart); if ((e) < 64) a0 = (c.lane == (e)) ? tot : a0; else a1 = (c.lane == (e) - 64) ? tot : a1; } while (0)
#pragma unroll
        for (int u = 0; u < 8; ++u) LOADROW(U8, u, u);
        float upart;
        for (int eb = 0; eb < 120; eb += 8) {
#pragma unroll
            for (int u = 0; u < 8; ++u) { const int e = eb + u; UROW(u, e); LOADROW(U8, e + 8, u); UPUT(e); }
        }
#pragma unroll
        for (int u = 0; u < 8; ++u) { const int e = 120 + u; UROW(u, e); UPUT(e); }
#undef UROW
#undef UPUT
        const float h0 = gelu_tanh(a0 * su0) * gw0 * sv0, h1 = gelu_tanh(a1 * su1) * gw1 * sv1;
        float* hw = (float*)(p->ws + hdst) + (size_t)t * 128; hw[c.lane] = h0; hw[64 + c.lane] = h1;
#undef LOADROW
#undef ROWIDX
    }
}

__device__ __forceinline__ void phase_pgather_us(KP p, int l, size_t hdst) {
    const Ctx c = make_ctx();
    const bf16* HN = (const bf16*)(p->ws + WS_HN); const int* EIDX = (const int*)(p->ws + WS_EIDX); const float* GWT = (const float*)(p->ws + WS_GW);
    const unsigned char* U8 = p->ws + WS_U; const float* SU = (const float*)(p->ws + WS_SCL); const float* SV = SU + 16384;
    const int eg = c.lane >> 3, pp = c.lane & 7;
    LAS int* wl = (LAS int*)(c.lds + 1024 + c.wave * 4096);
    for (int tg = c.gw; tg < T / 4; tg += c.NGW) { const int tw = 4 * tg;
#pragma unroll
        for (int k = 0; k < 4; ++k) { const size_t tb = (size_t)(tw + k) * 128; wl[128 * k + c.lane] = EIDX[tb + c.lane] << 7; wl[128 * k + 64 + c.lane] = EIDX[tb + 64 + c.lane] << 7; }
        LDS_WAIT();
        float acc[4][16];
#pragma unroll
        for (int k = 0; k < 4; ++k)
#pragma unroll
            for (int i = 0; i < 16; ++i) acc[k][i] = 0.f;
        u32x4 xn[2];
        { const u32x4* xp = (const u32x4*)(HN + (size_t)tw * D + 16 * pp); xn[0] = xp[0]; xn[1] = xp[1]; }
        u32x4 RA[8], RB[8];
#define PU_ISSUE(RR, ubase, k, hf) do { const LAS int* _oi = wls + 128 * (k) + eg + 64 * (hf); _Pragma("unroll") for (int i = 0; i < 8; ++i) RR[i] = *(const u32x4*)((ubase) + ((unsigned)_oi[8 * i] + pp16)); } while (0)
#define PU_CONSUME(RR, k, hf) do { _Pragma("unroll") for (int i = 0; i < 8; ++i) { const unsigned wd[4] = {RR[i].x, RR[i].y, RR[i].z, RR[i].w}; float _a = acc[k][8 * (hf) + i]; \
                _Pragma("unroll") for (int r = 0; r < 4; ++r) { const pg8::bf16x2_t lo = __builtin_amdgcn_cvt_scalef32_pk_bf16_fp8((int)wd[r], 1.0f, false), hh = __builtin_amdgcn_cvt_scalef32_pk_bf16_fp8((int)wd[r], 1.0f, true); \
                    _a = __builtin_amdgcn_fdot2_f32_bf16(lo, xb[2 * r], _a, false); _a = __builtin_amdgcn_fdot2_f32_bf16(hh, xb[2 * r + 1], _a, false); }     \
                asm volatile("" : "+v"(_a)); acc[k][8 * (hf) + i] = _a; } } while (0)
        LAS int* wls = wl; asm volatile("" : "+v"(wls));
        const unsigned pp16 = 16u * (unsigned)pp;
        PU_ISSUE(RA, U8, 0, 0);
#pragma unroll 1
        for (int s = 0; s < 16; ++s) {
            asm volatile("" : "+v"(wls));
            size_t uoff = (size_t)s * (16384 * 128); asm volatile("" : "+s"(uoff)); const unsigned char* ub = U8 + uoff;
            const int sn = s < 15 ? s + 1 : 15;
            size_t uoffn = (size_t)sn * (16384 * 128); asm volatile("" : "+s"(uoffn)); const unsigned char* ubn = U8 + uoffn;
#pragma unroll
            for (int k = 0; k < 4; ++k) {
                pg8::bf16x2_t xb[8];
                { const u32x4 xa = xn[0], xc = xn[1]; const unsigned xw[8] = {xa.x, xa.y, xa.z, xa.w, xc.x, xc.y, xc.z, xc.w};
#pragma unroll
                  for (int j = 0; j < 8; ++j) xb[j] = __builtin_bit_cast(pg8::bf16x2_t, xw[j]); }
                { const u32x4* xp = (const u32x4*)(HN + (size_t)(tw + ((k + 1) & 3)) * D + 128 * (k < 3 ? s : sn) + 16 * pp); xn[0] = xp[0]; xn[1] = xp[1]; }
                PU_ISSUE(RB, ub, k, 1); __builtin_amdgcn_sched_barrier(0);
                PU_CONSUME(RA, k, 0); __builtin_amdgcn_sched_barrier(0);
                if (k < 3) PU_ISSUE(RA, ub, k + 1, 0); else PU_ISSUE(RA, ubn, 0, 0);
                __builtin_amdgcn_sched_barrier(0);
                PU_CONSUME(RB, k, 1); __builtin_amdgcn_sched_barrier(0);
            }
        }
#undef PU_ISSUE
#undef PU_CONSUME
        int ev[4][2]; float suv[4][2], svv[4][2], gwv[4][2];
#pragma unroll
        for (int k = 0; k < 4; ++k) { ev[k][0] = wl[128 * k + c.lane] >> 7; ev[k][1] = wl[128 * k + 64 + c.lane] >> 7; }
        LDS_WAIT(); asm volatile("" ::: "memory");
#pragma unroll
        for (int k = 0; k < 4; ++k)
#pragma unroll
            for (int hf = 0; hf < 2; ++hf) { const int e = ev[k][hf]; suv[k][hf] = SU[e]; svv[k][hf] = SV[e]; gwv[k][hf] = GWT[(size_t)(tw + k) * 128 + 64 * hf + c.lane]; }
        asm volatile("" ::: "memory");
#pragma unroll
        for (int k = 0; k < 4; ++k)
#pragma unroll
            for (int i = 0; i < 16; ++i) { float q = acc[k][i];
                q += __builtin_bit_cast(float, __builtin_amdgcn_mov_dpp(__builtin_bit_cast(int, q), 0xB1, 0xf, 0xf, true));
                q += __builtin_bit_cast(float, __builtin_amdgcn_mov_dpp(__builtin_bit_cast(int, q), 0x4E, 0xf, 0xf, true));
                q += __builtin_bit_cast(float, __builtin_amdgcn_mov_dpp(__builtin_bit_cast(int, q), 0x141, 0xf, 0xf, true));
                if (pp == 0) ((LAS float*)wl)[128 * k + eg + 8 * i] = q; }
        LDS_WAIT(); asm volatile("" ::: "memory");
        float hv[4][2];
#pragma unroll
        for (int k = 0; k < 4; ++k)
#pragma unroll
            for (int hf = 0; hf < 2; ++hf) { const float a = ((const LAS float*)wl)[128 * k + 64 * hf + c.lane]; hv[k][hf] = gelu_tanh(a * suv[k][hf]) * gwv[k][hf] * svv[k][hf]; }
#pragma unroll
        for (int k = 0; k < 4; ++k) { float* hw = (float*)(p->ws + hdst) + (size_t)(tw + k) * 128; hw[c.lane] = hv[k][0]; hw[64 + c.lane] = hv[k][1]; }
        LDS_WAIT();
    }
}
__device__ __forceinline__ void phase_pgather_v(KP p, int l, int qoff) {
    const Ctx c = make_ctx();
    const int* EIDX = (const int*)(p->ws + WS_EIDX); const float* H = (const float*)(p->ws + WS_GW); const unsigned char* V8 = p->ws + WS_V; float* YP = (float*)(p->ws + WS_YP);
    int* qv = (int*)(p->ws + WS_QV) + l * 16 + qoff; LAS int* sblk = (LAS int*)c.lds;
    const int xcc = (int)(xb_xcc_id() & 7u);
    for (int round = 0; round < 18; ++round) {
        int sl;
        if (round < 2) sl = xcc + 8 * round;
        else { if (round == 2) { __syncthreads(); if (c.tid < 16) sblk[8 + c.tid] = __hip_atomic_load(qv + c.tid, __ATOMIC_RELAXED, __HIP_MEMORY_SCOPE_AGENT); __syncthreads(); }
               sl = (xcc + 1 + (round - 2)) & 15; if (sblk[8 + sl] >= T / 64) continue; }
        __syncthreads(); if (c.tid == 0) sblk[0] = atomicAdd(qv + sl, 1); __syncthreads();
        int blk = sblk[0];
        while (blk < T / 64) {
            int nxt = 0; if (c.tid == 0) nxt = atomicAdd(qv + sl, 1);
            const int eg = c.lane >> 3, pp = c.lane & 7;
            const unsigned char* vb = V8 + (size_t)sl * (16384 * 128) + 16 * pp;
            LAS int* wl = (LAS int*)(c.lds + 1024 + c.wave * 8192);
            const int tw = blk * 64 + c.wave * 8;
#pragma unroll
            for (int k = 0; k < 8; ++k) { const size_t tb = (size_t)(tw + k) * 128;
                wl[256 * k + c.lane] = EIDX[tb + c.lane] << 7; wl[256 * k + 64 + c.lane] = EIDX[tb + 64 + c.lane] << 7;
                wl[256 * k + 128 + c.lane] = __builtin_bit_cast(int, H[tb + c.lane]); wl[256 * k + 192 + c.lane] = __builtin_bit_cast(int, H[tb + 64 + c.lane]); }
            LDS_WAIT();
            u32x4 RA[8], RB[8];
#define PV_ISSUE(RR, k, hf) do { const LAS int* _oi = wl + 256 * (k) + eg + 64 * (hf); _Pragma("unroll") for (int i = 0; i < 8; ++i) RR[i] = *(const u32x4*)(vb + (unsigned)_oi[8 * i]); } while (0)
#define PV_CONSUME(RR, k, hf) do { const LAS float* _oh = (const LAS float*)(wl + 256 * (k) + 128 + eg + 64 * (hf)); \
                _Pragma("unroll") for (int i = 0; i < 8; ++i) { const float he = _oh[8 * i]; const unsigned wd[4] = {RR[i].x, RR[i].y, RR[i].z, RR[i].w}; \
                    _Pragma("unroll") for (int r = 0; r < 4; ++r) { const f32x2 lo = __builtin_amdgcn_cvt_pk_f32_fp8((int)wd[r], false), hh = __builtin_amdgcn_cvt_pk_f32_fp8((int)wd[r], true); \
                        y[4 * r] += he * lo.x; y[4 * r + 1] += he * lo.y; y[4 * r + 2] += he * hh.x; y[4 * r + 3] += he * hh.y; } } } while (0)
            PV_ISSUE(RA, 0, 0);
#pragma unroll 1
            for (int k = 0; k < 8; ++k) {
                float y[16];
#pragma unroll
                for (int q = 0; q < 16; ++q) y[q] = 0.f;
                PV_ISSUE(RB, k, 1);
                PV_CONSUME(RA, k, 0);
                if (k + 1 < 8) PV_ISSUE(RA, k + 1, 0);
                PV_CONSUME(RB, k, 1);
#pragma unroll
                for (int q = 0; q < 16; ++q) { y[q] += __shfl_xor(y[q], 8); y[q] += __shfl_xor(y[q], 16); y[q] += __shfl_xor(y[q], 32); }
                if (eg == 0) { f32x4* yo = (f32x4*)(YP + (size_t)(tw + k) * D + 128 * sl + 16 * pp);
                    yo[0] = (f32x4){y[0], y[1], y[2], y[3]}; yo[1] = (f32x4){y[4], y[5], y[6], y[7]}; yo[2] = (f32x4){y[8], y[9], y[10], y[11]}; yo[3] = (f32x4){y[12], y[13], y[14], y[15]}; }
            }
#undef PV_ISSUE
#undef PV_CONSUME
            __syncthreads(); if (c.tid == 0) sblk[0] = nxt; __syncthreads(); blk = sblk[0];
        }
    }
    __syncthreads();
}
__device__ __forceinline__ void phase_pgather_vs(KP p, int l, size_t ydst) {
    const Ctx c = make_ctx();
    const int* EIDX = (const int*)(p->ws + WS_EIDX); const float* H = (const float*)(p->ws + WS_GW); const unsigned char* V8 = p->ws + WS_V; float* YP = (float*)(p->ws + ydst);
    const int eg = c.lane >> 3, pp = c.lane & 7; const unsigned pp16 = 16u * (unsigned)pp;
    const bool b3 = (c.lane & 8) != 0, b4 = (c.lane & 16) != 0, b5 = (c.lane & 32) != 0;
    const int ocol = 16 * pp + (b5 ? 8 : 0) + (b4 ? 4 : 0) + (b3 ? 2 : 0);
    LAS int* wl = (LAS int*)(c.lds + 1024 + c.wave * 4096);
    for (int tg = c.gw; tg < T / 4; tg += c.NGW) { const int tw = 4 * tg;
#pragma unroll
        for (int k = 0; k < 4; ++k) { const size_t tb = (size_t)(tw + k) * 128;
            wl[256 * k + c.lane] = EIDX[tb + c.lane] << 7; wl[256 * k + 64 + c.lane] = EIDX[tb + 64 + c.lane] << 7;
            wl[256 * k + 128 + c.lane] = __builtin_bit_cast(int, H[tb + c.lane]); wl[256 * k + 192 + c.lane] = __builtin_bit_cast(int, H[tb + 64 + c.lane]); }
        LDS_WAIT();
        u32x4 RA[8], RB[8];
#define PV_ISSUE(RR, ubase, k, hf) do { const LAS int* _oi = wl + 256 * (k) + eg + 64 * (hf); _Pragma("unroll") for (int i = 0; i < 8; ++i) RR[i] = *(const u32x4*)((ubase) + ((unsigned)_oi[8 * i] + pp16)); } while (0)
#define PV_CONSUME(RR, k, hf) do { const LAS float* _oh = (const LAS float*)(wl + 256 * (k) + 128 + eg + 64 * (hf)); \
            _Pragma("unroll") for (int i = 0; i < 8; ++i) { const float he = _oh[8 * i]; const f32x2 he2 = (f32x2){he, he}; const unsigned wd[4] = {RR[i].x, RR[i].y, RR[i].z, RR[i].w}; \
                _Pragma("unroll") for (int r = 0; r < 4; ++r) { const f32x2 lo = __builtin_amdgcn_cvt_pk_f32_fp8((int)wd[r], false), hh = __builtin_amdgcn_cvt_pk_f32_fp8((int)wd[r], true); \
                    y2[2 * r] = lo * he2 + y2[2 * r]; y2[2 * r + 1] = hh * he2 + y2[2 * r + 1]; } } } while (0)
        PV_ISSUE(RA, V8, 0, 0);
#pragma unroll 1
        for (int it = 0; it < 64; ++it) { const int s = it >> 2, k = it & 3;
            const int itn = it < 63 ? it + 1 : 63, sn = itn >> 2, kn = itn & 3;
            size_t voff = (size_t)s * (16384 * 128), voffn = (size_t)sn * (16384 * 128); asm volatile("" : "+s"(voff), "+s"(voffn)); const unsigned char* vb = V8 + voff; const unsigned char* vbn = V8 + voffn;
            f32x2 y2[8];
#pragma unroll
            for (int q = 0; q < 8; ++q) y2[q] = (f32x2){0.f, 0.f};
            PV_ISSUE(RB, vb, k, 1);
            PV_CONSUME(RA, k, 0);
            PV_ISSUE(RA, vbn, kn, 0);
            PV_CONSUME(RB, k, 1);
            f32x2 a4[4], a2[2], a1;
#define SWAPADD(dst, lo_, hi_, INS) do { float _ax = (lo_).x, _bx = (hi_).x, _ay = (lo_).y, _by = (hi_).y; \
                asm volatile("s_nop 1\n\t" INS " %0, %1" : "+v"(_ax), "+v"(_bx)); asm volatile("s_nop 1\n\t" INS " %0, %1" : "+v"(_ay), "+v"(_by)); \
                dst = (f32x2){_ax + _bx, _ay + _by}; } while (0)
#pragma unroll
            for (int q = 0; q < 4; ++q) SWAPADD(a4[q], y2[q], y2[4 + q], "v_permlane32_swap_b32");
#pragma unroll
            for (int q = 0; q < 2; ++q) SWAPADD(a2[q], a4[q], a4[2 + q], "v_permlane16_swap_b32");
#undef SWAPADD
            { const f32x2 keep = b3 ? a2[1] : a2[0], send = b3 ? a2[0] : a2[1];
              a1 = keep + (f32x2){__shfl_xor(send.x, 8), __shfl_xor(send.y, 8)}; }
            *(f32x2*)(YP + (size_t)(tw + k) * D + 128 * s + ocol) = a1;
        }
#undef PV_ISSUE
#undef PV_CONSUME
        LDS_WAIT();
    }
}
__device__ __forceinline__ void phase_pgather_e(KP p, int l) {
    const Ctx c = make_ctx();
    float* X = (float*)(p->ws + WS_X); const float* YP = (const float*)(p->ws + WS_YP);
    const float* g2 = (const float*)(p->ws + WS_MOD) + (size_t)l * NBATCH * 12288 + 5 * D;
    asm volatile("s_waitcnt vmcnt(0)" ::: "memory");
    for (int tq = 4 * c.gw; tq < T; tq += ((tq & 3) == 3) ? 4 * c.NGW - 3 : 1) { const int t = tq;
        float y[32];
#pragma unroll
        for (int j = 0; j < 2; ++j)
#pragma unroll
            for (int q = 0; q < 4; ++q) { const f32x4 yy = ((const f32x4*)(YP + (size_t)t * D))[256 * j + 4 * c.lane + q]; y[16 * j + 4 * q] = yy[0]; y[16 * j + 4 * q + 1] = yy[1]; y[16 * j + 4 * q + 2] = yy[2]; y[16 * j + 4 * q + 3] = yy[3]; }
        f32x4* xr = (f32x4*)(X + (size_t)t * D); const f32x4* gp = (const f32x4*)(g2 + (size_t)(t >> 11) * 12288);
        f32x4 xn[8]; float ss = 0.f;
#pragma unroll
        for (int j = 0; j < 2; ++j)
#pragma unroll
            for (int q = 0; q < 4; ++q) { const int i4 = 256 * j + 4 * c.lane + q; const f32x4 yy = (f32x4){y[16 * j + 4 * q], y[16 * j + 4 * q + 1], y[16 * j + 4 * q + 2], y[16 * j + 4 * q + 3]};
                const f32x4 v = xr[i4] + gp[i4] * yy; xn[4 * j + q] = v; ss += (v[0] * v[0] + v[1] * v[1]) + (v[2] * v[2] + v[3] * v[3]); }
        const float rstd = 1.0f / sqrtf(wave_total(ss) * (1.0f / D) + EPS);
        if (l == 0) {
            const float* mod1 = (const float*)(p->ws + WS_MOD) + (size_t)(NBATCH + (t >> 11)) * 12288;
            const f32x4* n1 = (const f32x4*)(p->norm1_g + D); const f32x4* shp = (const f32x4*)mod1; const f32x4* scp = (const f32x4*)(mod1 + D);
            u32x2* ho = (u32x2*)((bf16*)(p->ws + WS_HN) + (size_t)t * D); float am8 = 0.f;
            f32x4 n1v[8], scv[8], shv[8];
#pragma unroll
            for (int j = 0; j < 2; ++j)
#pragma unroll
                for (int q = 0; q < 4; ++q) { const int i4 = 256 * j + 4 * c.lane + q; n1v[4 * j + q] = n1[i4]; scv[4 * j + q] = scp[i4]; shv[4 * j + q] = shp[i4]; }
#pragma unroll
            for (int j = 0; j < 2; ++j)
#pragma unroll
                for (int q = 0; q < 4; ++q) { const int i4 = 256 * j + 4 * c.lane + q; xr[i4] = xn[4 * j + q];
                    const f32x4 yv = xn[4 * j + q] * rstd * n1v[4 * j + q] * (scv[4 * j + q] + 1.0f) + shv[4 * j + q]; u32x2 w; w.x = pk2(yv[0], yv[1]); w.y = pk2(yv[2], yv[3]); ho[i4] = w;
                    xn[4 * j + q] = yv; am8 = fmaxf(am8, fmaxf(fmaxf(fabsf(yv[0]), fabsf(yv[1])), fmaxf(fabsf(yv[2]), fabsf(yv[3])))); }
            {
                am8 = wave_amax(am8); const float q8 = am8 > 0.f ? 240.0f / am8 : 1.0f; unsigned* o1 = (unsigned*)(p->ws + WS_HN8 + (size_t)t * D);
#pragma unroll
                for (int j = 0; j < 2; ++j)
#pragma unroll
                    for (int q = 0; q < 4; ++q) { const f32x4 yv = xn[4 * j + q]; int w = 0; w = __builtin_amdgcn_cvt_pk_fp8_f32(yv[0] * q8, yv[1] * q8, w, false); w = __builtin_amdgcn_cvt_pk_fp8_f32(yv[2] * q8, yv[3] * q8, w, true); o1[256 * j + 4 * c.lane + q] = (unsigned)w; }
                if (c.lane == 0) ((float*)(p->ws + WS_RS))[t] = am8 > 0.f ? am8 * (1.0f / 240.0f) : 1.0f; }
        } else {
            const f32x4* fg = (const f32x4*)p->final_g; f32x4* oo = (f32x4*)(p->out + (size_t)t * D);
            f32x4 fgv[8];
#pragma unroll
            for (int j = 0; j < 2; ++j)
#pragma unroll
                for (int q = 0; q < 4; ++q) fgv[4 * j + q] = fg[256 * j + 4 * c.lane + q];
#pragma unroll
            for (int j = 0; j < 2; ++j)
#pragma unroll
                for (int q = 0; q < 4; ++q) { const int i4 = 256 * j + 4 * c.lane + q; oo[i4] = xn[4 * j + q] * rstd * fgv[4 * j + q]; }
        }
    }
}

constexpr int PH_PER_LAYER = 13, PH_TOTAL = 2 * PH_PER_LAYER;
__global__ void __launch_bounds__(NTHR, 2) hse_fwd(P p_unused) {
    extern __shared__ __attribute__((aligned(16))) unsigned char lds_raw[];
    {
        LAS unsigned char* lds = (LAS unsigned char*)lds_raw;
        for (int u = threadIdx.x; u < (LDS_BYTES - LDSCTL_OFF) / 4; u += NTHR) ((LAS unsigned*)(lds + LDSCTL_OFF))[u] = 0u;
        __syncthreads();
    }
#if MK_ONE_LAUNCH
    XcdBarrier bar = xcd_barrier_post((unsigned*)(kargs()->ws + WS_CTL) + CW_BAR, (volatile LAS unsigned*)((LAS unsigned char*)lds_raw + LDSCTL_OFF) + 8);
#define GRID_BAR() xcd_barrier(bar)
#else
#define GRID_BAR() do {} while (0)
#endif
    const int lo = kargs()->ph_lo, hi = kargs()->ph_hi;
#define IN(k) (lo <= (k) && (k) < hi)
#define SEAM(k) do { if (IN(k) && IN((k) + 1)) GRID_BAR(); } while (0)
#define WSP(q, off) ((q)->ws + (off))
#define MODL(q, l) ((const float*)((q)->ws + WS_MOD) + (size_t)(l) * NBATCH * 12288)
#define XIN(q, l) (((l) == 0) ? (q)->x : (const float*)((q)->ws + WS_X))
    for (int l = 0; l < NLAYER; ++l) {
        const int pb = l * PH_PER_LAYER;
        if (IN(pb + 0)) { asm volatile("; MKPH 0" ::: "memory"); phase_prep(kargs(), l); if (l == 0) gate_col_amax(kargs()); else gate_transpose_f8(kargs(), l); if (PROBE_PHASE == 0) phase_prep(kargs(), l); } SEAM(pb + 0);
        if (IN(pb + 1) && l == 0) { asm volatile("; MKPH 1" ::: "memory"); KP q = kargs(); phase_norm_mod<true>(XIN(q, l), q->norm1_g + (size_t)l * D, MODL(q, l) + 0 * D, MODL(q, l) + 1 * D, (bf16*)WSP(q, WS_HN), WSP(q, WS_HN8), (float*)WSP(q, WS_RS)); gate_transpose_f8(kargs(), l); } if (l == 0) SEAM(pb + 1);
        if (IN(pb + 2)) { asm volatile("; MKPH 2" ::: "memory");
#if NAIVE_GEMM
            naive_proj(kargs(), l);
#else
            KP q = kargs(); LAS unsigned char* lds = (LAS unsigned char*)lds_raw;
            { pg8::Gemm g{(const bf16*)WSP(q, WS_HN), (const bf16*)WSP(q, WS_WIN), T, NPROJ_BF, D, 0, 0}; pg8::StaticOrder S; S.init(T, NPROJ_BF, (int)gridDim.x, (int)blockIdx.x);
              pg8::EpiBf16 E{(bf16*)WSP(q, WS_PROJ) + BF_LO, NPROJ};
              pg8::gemm_phase<pg8::EpiBf16, pg8::StaticOrder, true, true>(lds, g, S, E); if (PROBE_PHASE == 2) { pg8::gemm_phase<pg8::EpiBf16, pg8::StaticOrder, true, true>(lds, g, S, E); } }
            { KP q2 = kargs();
              pg8::Gemm g{(const bf16*)WSP(q2, WS_HN8), (const bf16*)WSP(q2, WS_WG8), T, N8, D, 0, 0}; pg8::F8BalOrder S; S.so.init(T, N8, (int)gridDim.x, (int)gridDim.x - 1 - (int)blockIdx.x); S.c = (int)blockIdx.x;
              pg8::EpiF8 E{(bf16*)WSP(q2, WS_PROJ), (const float*)WSP(q2, WS_RS), (const float*)WSP(q2, WS_CSD), (const float*)WSP(q2, WS_ROPE)};
              pg8::gemm_phase<pg8::EpiF8, pg8::F8BalOrder, true, true, true>(lds, g, S, E); if (PROBE_PHASE == 2) { pg8::gemm_phase<pg8::EpiF8, pg8::F8BalOrder, true, true, true>(lds, g, S, E); } }
#endif
        } SEAM(pb + 2);
        if (IN(pb + 3)) { asm volatile("; MKPH 3" ::: "memory"); phase_conv(kargs(), l); phase_sg(kargs(), l); phase_band(kargs(), l); phase_d1(kargs(), l);
            if (PROBE_PHASE == 30) phase_conv(kargs(), l); if (PROBE_PHASE == 31) phase_sg(kargs(), l); if (PROBE_PHASE == 32) phase_band(kargs(), l); if (PROBE_PHASE == 33) phase_d1(kargs(), l); } SEAM(pb + 3);
        if (IN(pb + 4)) { asm volatile("; MKPH 4" ::: "memory"); phase_d2(kargs(), l); if (PROBE_PHASE == 4) phase_d2(kargs(), l); } SEAM(pb + 4);
        if (IN(pb + 5)) { asm volatile("; MKPH 5" ::: "memory");
#if NAIVE_GEMM
            naive_branch(kargs(), l);
#else
            KP q = kargs(); LAS unsigned char* lds = (LAS unsigned char*)lds_raw;
            pg8::Gemm g{(const bf16*)WSP(q, WS_OBR), (const bf16*)WSP(q, WS_WB), T, D, BRW, (size_t)T * BRW * 2, (size_t)D * BRW * 2};
            pg8::BatchOrder<4> S; S.so.init(T, D, (int)gridDim.x, (int)blockIdx.x);
            pg8::EpiBranch E{(bf16*)WSP(q, WS_Y), (const bf16*)WSP(q, WS_PROJ)};
            pg8::gemm_phase<pg8::EpiBranch, pg8::BatchOrder<4>, true, true>(lds, g, S, E); if (PROBE_PHASE == 5) { pg8::gemm_phase<pg8::EpiBranch, pg8::BatchOrder<4>, true, true>(lds, g, S, E); }
#endif
        } SEAM(pb + 5);
        if (IN(pb + 6)) { asm volatile("; MKPH 6" ::: "memory");
#if NAIVE_GEMM
            { KP q = kargs(); naive_wo(q, l, XIN(q, l)); }
#else
            KP q = kargs(); LAS unsigned char* lds = (LAS unsigned char*)lds_raw;
            pg8::Gemm g{(const bf16*)WSP(q, WS_Y), (const bf16*)WSP(q, WS_WO), T, D, D, 0, 0}; pg8::StaticOrder S; S.init(T, D, (int)gridDim.x, (int)blockIdx.x);
            pg8::EpiResid E{XIN(q, l), (float*)WSP(q, WS_X), MODL(q, l) + 2 * D};
            pg8::gemm_phase<pg8::EpiResid, pg8::StaticOrder, true, true>(lds, g, S, E);
#endif
        } SEAM(pb + 6);
        if (IN(pb + 7)) { asm volatile("; MKPH 7" ::: "memory"); KP q = kargs(); phase_norm_mod<false>((const float*)WSP(q, WS_X), q->norm2_g + (size_t)l * D, MODL(q, l) + 3 * D, MODL(q, l) + 4 * D, (bf16*)WSP(q, WS_HN), nullptr, nullptr); } SEAM(pb + 7);
        if (IN(pb + 8)) { asm volatile("; MKPH 8" ::: "memory");
#if NAIVE_GEMM
            naive_wq(kargs(), l);
#else
            KP q = kargs(); LAS unsigned char* lds = (LAS unsigned char*)lds_raw;
            pg8::Gemm g{(const bf16*)WSP(q, WS_HN), (const bf16*)WSP(q, WS_WQ), T, D, D, 0, 0}; pg8::StaticOrder S; S.init(T, D, (int)gridDim.x, (int)blockIdx.x);
            pg8::EpiBf16 E{(bf16*)WSP(q, WS_QP), D};
            pg8::gemm_phase<pg8::EpiBf16, pg8::StaticOrder, true, true>(lds, g, S, E); if (PROBE_PHASE == 8) { pg8::gemm_phase<pg8::EpiBf16, pg8::StaticOrder, true, true>(lds, g, S, E); }
#endif
        } SEAM(pb + 8);
        if (IN(pb + 9)) { asm volatile("; MKPH 9" ::: "memory"); phase_psel(kargs(), l); if (PROBE_PHASE == 9) phase_psel(kargs(), l); } SEAM(pb + 9);
        if (IN(pb + 10)) { asm volatile("; MKPH 10" ::: "memory"); phase_pgather_us(kargs(), l, WS_GW); if (PROBE_PHASE == 10) phase_pgather_us(kargs(), l, WS_SCI); } SEAM(pb + 10);
        if (IN(pb + 11)) { asm volatile("; MKPH 11" ::: "memory"); phase_pgather_vs(kargs(), l, WS_YP); if (PROBE_PHASE == 11) phase_pgather_vs(kargs(), l, WS_YP); }
        if (IN(pb + 12)) { asm volatile("; MKPH 12" ::: "memory"); phase_pgather_e(kargs(), l); } SEAM(pb + 12);
    }
#undef IN
#undef SEAM
}

extern "C" void kernel_launch(void* const* d_in, const int* in_sizes, int n_in, void* d_out, int out_size, void* d_ws, size_t ws_size, hipStream_t stream) {
    static int grid = 0;
    if (grid == 0) {
        if (n_in != 19 || out_size != T * D || ws_size < WS_END) { fprintf(stderr, "kernel_launch: unexpected problem (n_in %d out %d ws %zu)\n", n_in, out_size, ws_size); grid = -1; return; }
        int dev = 0, cus = 0, per_cu = 0;
        if (hipGetDevice(&dev) != hipSuccess || hipDeviceGetAttribute(&cus, hipDeviceAttributeMultiprocessorCount, dev) != hipSuccess) { grid = -1; return; }
        if (hipFuncSetAttribute((const void*)hse_fwd, hipFuncAttributeMaxDynamicSharedMemorySize, LDS_BYTES) != hipSuccess) { fprintf(stderr, "kernel_launch: hipFuncSetAttribute failed\n"); grid = -1; return; }
        if (hipOccupancyMaxActiveBlocksPerMultiprocessor(&per_cu, (const void*)hse_fwd, NTHR, LDS_BYTES) != hipSuccess || per_cu < 1) { fprintf(stderr, "kernel_launch: occupancy query says %d\n", per_cu); }
        (void)hipGetLastError();
        grid = cus;
    }
    if (grid < 0) return;
    if (hipMemsetAsync((char*)d_ws + WS_CTL, 0, CTL_ZERO_BYTES, stream) != hipSuccess) return;
    P p{};
    p.x = (const float*)d_in[0]; p.c = (const float*)d_in[1]; p.ada_w = (const float*)d_in[2]; p.ada_b = (const float*)d_in[3]; p.norm1_g = (const float*)d_in[4]; p.norm2_g = (const float*)d_in[5];
    p.w_in = (const float*)d_in[6]; p.conv_w = (const float*)d_in[7]; p.sg_norm_g = (const float*)d_in[8]; p.sg_w = (const float*)d_in[9]; p.sg_b = (const float*)d_in[10]; p.rel_bias = (const float*)d_in[11];
    p.w_branch = (const float*)d_in[12]; p.w_o = (const float*)d_in[13]; p.peer_wq = (const float*)d_in[14]; p.peer_keys = (const float*)d_in[15]; p.peer_u = (const float*)d_in[16]; p.peer_v = (const float*)d_in[17]; p.final_g = (const float*)d_in[18];
    p.out = (float*)d_out; p.ws = (unsigned char*)d_ws;
#if MK_ONE_LAUNCH
    p.ph_lo = 0; p.ph_hi = PH_TOTAL;
    hipLaunchKernelGGL(hse_fwd, dim3(grid), dim3(NTHR), LDS_BYTES, stream, p);
#else
    for (int ph = 0; ph < PH_TOTAL; ++ph) { p.ph_lo = ph; p.ph_hi = ph + 1; hipLaunchKernelGGL(hse_fwd, dim3(grid), dim3(NTHR), LDS_BYTES, stream, p); }
#endif
}
```
